# Optimizing an MI355X kernel written in HIP

```python
import math
import jax, jax.numpy as jnp
from jax import lax
import numpy as np

D_MODEL = 1024
BATCH = 4
SEQ = 4096
DEPTH = 2

EPS = 1e-6
GLA_HEADS = 4
GLA_HDK = 48
GLA_HDV = 96
GLA_DK = GLA_HEADS * GLA_HDK
GLA_DV = GLA_HEADS * GLA_HDV
GLA_LR = 16
GLA_TAU = 16.0
GLA_CHUNK = 64
SB_HEADS = 6
SB_HD = 64
SB_W = SB_HEADS * SB_HD
SB_BLOCK = 128
POOL_WINDOWS = (2, 4, 8, 16)
POOL_GROUPS = 4
POOL_GC = 64
POOL_W = POOL_GROUPS * POOL_GC
POOL_MAX = 16
D_MIX = GLA_DV + SB_W + POOL_W
PROJ_SIZES = (GLA_DK, GLA_DK, GLA_DV, GLA_DV, GLA_LR, SB_W, SB_W, SB_W, POOL_W)
D_PROJ = GLA_DK * 2 + GLA_DV * 2 + GLA_LR + SB_W * 3 + POOL_W
MOE_GROUPS = 4
MOE_EPG = 8
N_EXPERTS = MOE_GROUPS * MOE_EPG
MOE_TOPK = 2
D_EXPERT = 256
PLE_DIM = 256

kernel_name = "hybrid_gla_stickbreak_pool_hmoe"


def rmsnorm(x, g):
    xf = x.astype(jnp.float32)
    y = xf * lax.rsqrt(jnp.mean(xf * xf, axis=-1, keepdims=True) + EPS)
    return (y * g.astype(jnp.float32)).astype(x.dtype)


def gla_mixer(q, k, v, g_out, lr, w_lr2, b_lr, norm_g):
    B, S, _ = q.shape
    n = S // GLA_CHUNK
    f32 = jnp.float32
    log_a = jax.nn.log_sigmoid((lr @ w_lr2 + b_lr).astype(f32)) / GLA_TAU

    def heads(t, dh):
        return t.reshape(B, n, GLA_CHUNK, GLA_HEADS, dh).transpose(0, 3, 1, 2, 4).astype(f32)

    qh = heads(q, GLA_HDK) * (GLA_HDK ** -0.5)
    kh = heads(k, GLA_HDK)
    vh = heads(v, GLA_HDV)
    b = jnp.cumsum(heads(log_a, GLA_HDK), axis=3)
    b_last = b[:, :, :, -1:, :]
    q_dec = qh * jnp.exp(b)
    k_in = kh * jnp.exp(-b)
    k_out = kh * jnp.exp(b_last - b)
    causal = jnp.tril(jnp.ones((GLA_CHUNK, GLA_CHUNK), dtype=bool))
    att = jnp.where(causal, jnp.einsum('bhncd,bhnsd->bhncs', q_dec, k_in), 0.0)
    o_intra = jnp.einsum('bhncs,bhnsv->bhncv', att, vh)
    kv = jnp.einsum('bhncd,bhncv->bhndv', k_out, vh)
    decay = jnp.exp(b_last[:, :, :, 0, :])

    def step(state, inp):
        kv_n, d_n = inp
        return d_n[..., None] * state + kv_n, state

    s0 = jnp.zeros((B, GLA_HEADS, GLA_HDK, GLA_HDV), f32)
    _, states = lax.scan(step, s0, (jnp.moveaxis(kv, 2, 0), jnp.moveaxis(decay, 2, 0)))
    states = jnp.moveaxis(states, 0, 2)
    o = o_intra + jnp.einsum('bhncd,bhndv->bhncv', q_dec, states)
    o = rmsnorm(o, norm_g)
    o = o.transpose(0, 2, 3, 1, 4).reshape(B, S, GLA_DV)
    return (o * jax.nn.silu(g_out.astype(f32))).astype(v.dtype)


def stick_breaking(q, k, v):
    B, S, _ = q.shape
    f32 = jnp.float32

    def heads(t):
        return t.reshape(B, S, SB_HEADS, SB_HD).transpose(0, 2, 1, 3).astype(f32)

    qh = heads(q) * (SB_HD ** -0.5)
    kh = heads(k)
    vh = heads(v)
    outs = []
    for blk in range(S // SB_BLOCK):
        q0 = blk * SB_BLOCK
        end = q0 + SB_BLOCK
        z = jnp.einsum('bhqd,bhkd->bhqk', qh[:, :, q0:end], kh[:, :, :end])
        qpos = q0 + jnp.arange(SB_BLOCK)[:, None]
        kpos = jnp.arange(end)[None, :]
        mask = kpos < qpos
        log_1m = jnp.where(mask, jax.nn.log_sigmoid(-z), 0.0)
        suffix = lax.cumsum(log_1m, axis=3, reverse=True) - log_1m
        a = jnp.where(mask, jnp.exp(jax.nn.log_sigmoid(z) + suffix), 0.0)
        outs.append(jnp.einsum('bhqk,bhkd->bhqd', a, vh[:, :, :end]))
    o = jnp.concatenate(outs, axis=2)
    return o.transpose(0, 2, 1, 3).reshape(B, S, SB_W).astype(v.dtype)


def pool_mixer(u, w_pool, scale):
    B, S, _ = u.shape
    uf = u.astype(jnp.float32)
    cs = jnp.pad(jnp.cumsum(uf, axis=1), ((0, 0), (POOL_MAX, 0), (0, 0)))
    pos = jnp.arange(S, dtype=jnp.float32)[None, :, None]
    groups = []
    for gi, w in enumerate(POOL_WINDOWS):
        c = slice(gi * POOL_GC, (gi + 1) * POOL_GC)
        wsum = cs[:, POOL_MAX:POOL_MAX + S, c] - cs[:, POOL_MAX - w:POOL_MAX - w + S, c]
        cnt = jnp.minimum(pos + 1.0, float(w))
        groups.append(wsum / cnt - uf[:, :, c])
    pooled = jnp.stack(groups, axis=2)
    y = jnp.einsum('bsgc,gcd->bsgd', pooled, w_pool.astype(jnp.float32)).reshape(B, S, POOL_W)
    return (y * scale.astype(jnp.float32)).astype(u.dtype)


def hier_moe(h, wg, bg, we, be, w_gate, w_up, w_down):
    B, S, D = h.shape
    t = h.reshape(B * S, D)
    f32 = jnp.float32
    g_prob = jax.nn.softmax((t @ wg + bg).astype(f32), axis=-1)
    g_w, g_idx = lax.top_k(g_prob, 1)
    g_onehot = jax.nn.one_hot(g_idx[:, 0], MOE_GROUPS, dtype=f32)
    e_logits = (t @ we + be).astype(f32).reshape(-1, MOE_GROUPS, MOE_EPG)
    e_in = jnp.einsum('tge,tg->te', e_logits, g_onehot)
    e_w, e_idx = lax.top_k(jax.nn.softmax(e_in, axis=-1), MOE_TOPK)
    e_w = e_w / jnp.sum(e_w, axis=-1, keepdims=True) * g_w
    expert_id = g_idx * MOE_EPG + e_idx
    combine = jnp.einsum('tk,tke->te', e_w, jax.nn.one_hot(expert_id, N_EXPERTS, dtype=f32))
    y = jnp.zeros((B * S, D), f32)
    for gi in range(MOE_GROUPS):
        sl = slice(gi * MOE_EPG, (gi + 1) * MOE_EPG)
        a = jnp.einsum('td,edf->tef', t, w_gate[sl])
        b = jnp.einsum('td,edf->tef', t, w_up[sl])
        hid = jax.nn.silu(a.astype(f32)) * b.astype(f32) * combine[:, sl, None]
        y = y + jnp.einsum('tef,efd->td', hid, w_down[sl].astype(f32))
    return y.reshape(B, S, D).astype(h.dtype)


def setup_inputs(seed: int = 0) -> dict:
    key = jax.random.key(seed)
    ks = jax.random.split(key, 24)
    L, D = DEPTH, D_MODEL
    nrm = lambda k, shape, s: jax.random.normal(k, shape, jnp.float32) * s
    gain = lambda k, shape: 1.0 + 0.02 * jax.random.normal(k, shape, jnp.float32)
    return {
        "x": nrm(ks[0], (BATCH, SEQ, D), 1.0),
        "p": nrm(ks[1], (DEPTH, BATCH, SEQ, PLE_DIM), 1.0),
        "norm1_g": gain(ks[2], (L, D)),
        "w_in": nrm(ks[3], (L, D, D_PROJ), D ** -0.5),
        "gla_w_lr2": nrm(ks[4], (L, GLA_LR, GLA_DK), GLA_LR ** -0.5),
        "gla_b_lr": nrm(ks[5], (L, GLA_DK), 0.1),
        "gla_norm_g": gain(ks[6], (L, GLA_HDV)),
        "pool_w": nrm(ks[7], (L, POOL_GROUPS, POOL_GC, POOL_GC), POOL_GC ** -0.5),
        "pool_scale": gain(ks[8], (L, POOL_W)),
        "w_out": nrm(ks[9], (L, D_MIX, D), D_MIX ** -0.5),
        "norm2_g": gain(ks[10], (L, D)),
        "router_group_w": nrm(ks[11], (L, D, MOE_GROUPS), D ** -0.5),
        "router_group_b": nrm(ks[12], (L, MOE_GROUPS), 0.01),
        "router_exp_w": nrm(ks[13], (L, D, N_EXPERTS), D ** -0.5),
        "router_exp_b": nrm(ks[14], (L, N_EXPERTS), 0.01),
        "exp_w_gate": nrm(ks[15], (L, N_EXPERTS, D, D_EXPERT), D ** -0.5),
        "exp_w_up": nrm(ks[16], (L, N_EXPERTS, D, D_EXPERT), D ** -0.5),
        "exp_w_down": nrm(ks[17], (L, N_EXPERTS, D_EXPERT, D), D_EXPERT ** -0.5),
        "ple_norm_g": gain(ks[18], (L, D)),
        "ple_gate_w": nrm(ks[19], (L, D, D), D ** -0.5),
        "ple_gate_b": nrm(ks[20], (L, D), 0.01),
        "ple_proj_w": nrm(ks[21], (L, PLE_DIM, D), PLE_DIM ** -0.5),
        "final_norm_g": gain(ks[22], (D,)),
    }


def reference(x, p, norm1_g, w_in, gla_w_lr2, gla_b_lr, gla_norm_g, pool_w, pool_scale, w_out,
              norm2_g, router_group_w, router_group_b, router_exp_w, router_exp_b,
              exp_w_gate, exp_w_up, exp_w_down, ple_norm_g, ple_gate_w, ple_gate_b, ple_proj_w,
              final_norm_g):
    h = x
    for i in range(DEPTH):
        hn = rmsnorm(h, norm1_g[i])
        proj = hn @ w_in[i]
        parts = []
        off = 0
        for sz in PROJ_SIZES:
            parts.append(proj[..., off:off + sz])
            off += sz
        g_q, g_k, g_v, g_o, g_lr, s_q, s_k, s_v, pool_u = parts
        o_gla = gla_mixer(g_q, g_k, g_v, g_o, g_lr, gla_w_lr2[i], gla_b_lr[i], gla_norm_g[i])
        o_sb = stick_breaking(s_q, s_k, s_v)
        o_pool = pool_mixer(pool_u, pool_w[i], pool_scale[i])
        mix = jnp.concatenate([o_gla, o_sb, o_pool], axis=-1)
        h = h + mix @ w_out[i]
        h = h + hier_moe(rmsnorm(h, norm2_g[i]), router_group_w[i], router_group_b[i],
                         router_exp_w[i], router_exp_b[i], exp_w_gate[i], exp_w_up[i], exp_w_down[i])
        gate = jax.nn.sigmoid((rmsnorm(h, ple_norm_g[i]) @ ple_gate_w[i] + ple_gate_b[i]).astype(jnp.float32))
        e = (p[i] @ ple_proj_w[i]).astype(jnp.float32)
        h = h + (gate * e).astype(h.dtype)
    return rmsnorm(h, final_norm_g)
```

```cpp
#include <hip/hip_runtime.h>
#include <cstdio>
#define HD __host__ __device__
#include <math.h>

namespace nv {
constexpr int D = 1024, DPROJ = 2576, DEPTH = 2;
constexpr int GH = 4, GDK = 48, GDV = 96, GLR = 16, GC = 64;
constexpr int SH = 6, SD = 64;
constexpr int PW = 256, PGC = 64;
constexpr int NE = 32, EPG = 8, NG = 4, DE = 256, PLE = 256;
constexpr int C_GQ = 0, C_GK = 192, C_GV = 384, C_GO = 768, C_LR = 1152, C_SQ = 1168, C_SK = 1552, C_SV = 1936, C_PU = 2320;

struct P {
    int B, S, T, pad_;
    const float* x; const float* pl;
    const float *norm1_g, *w_in, *w_lr2, *b_lr, *gnorm_g, *pool_w, *pool_scale, *w_out, *norm2_g;
    const float *rg_w, *rg_b, *re_w, *re_b, *wg, *wu, *wd, *ple_g, *ple_w, *ple_b, *ple_p, *final_g;
    float *H, *H2, *RSTD, *PROJ, *BC, *KV, *DEC, *ST, *ATT, *O, *MIX, *LOG, *EW, *HID;
    int* EID;
    float* out;
};

HD inline float sigmoidf_(float x) { return 1.0f / (1.0f + expf(-x)); }
HD inline float logsigf_(float x) { return fminf(x, 0.f) - log1pf(expf(-fabsf(x))); }
HD inline float siluf_(float x) { return x * sigmoidf_(x); }

HD inline void copy_body(long gid, const float* src, float* dst) { dst[gid] = src[gid]; }
HD inline void rstd_body(long m, const float* H, float* RSTD) {
    const float* r = H + m * D; float s = 0.f;
    for (int k = 0; k < D; ++k) s += r[k] * r[k];
    RSTD[m] = 1.0f / sqrtf(s / D + 1e-6f);
}
HD inline void gemm_rs_body(long gid, const float* A, const float* rstd, const float* g, const float* W, float* OUT, int N, int K) {
    const long m4 = gid / N; const int n = (int)(gid % N);
    const float* a0 = A + (m4 * 4 + 0) * K; const float* a1 = a0 + K; const float* a2 = a1 + K; const float* a3 = a2 + K;
    float s0 = 0.f, s1 = 0.f, s2 = 0.f, s3 = 0.f;
    for (int k = 0; k < K; ++k) { const float w = W[(long)k * N + n] * g[k]; s0 += a0[k] * w; s1 += a1[k] * w; s2 += a2[k] * w; s3 += a3[k] * w; }
    OUT[(m4 * 4 + 0) * N + n] = s0 * rstd[m4 * 4 + 0]; OUT[(m4 * 4 + 1) * N + n] = s1 * rstd[m4 * 4 + 1];
    OUT[(m4 * 4 + 2) * N + n] = s2 * rstd[m4 * 4 + 2]; OUT[(m4 * 4 + 3) * N + n] = s3 * rstd[m4 * 4 + 3];
}
HD inline void gemm_res_body(long gid, const float* A, const float* W, float* H, int N, int K) {
    const long m4 = gid / N; const int n = (int)(gid % N);
    const float* a0 = A + (m4 * 4 + 0) * K; const float* a1 = a0 + K; const float* a2 = a1 + K; const float* a3 = a2 + K;
    float s0 = 0.f, s1 = 0.f, s2 = 0.f, s3 = 0.f;
    for (int k = 0; k < K; ++k) { const float w = W[(long)k * N + n]; s0 += a0[k] * w; s1 += a1[k] * w; s2 += a2[k] * w; s3 += a3[k] * w; }
    H[(m4 * 4 + 0) * N + n] += s0; H[(m4 * 4 + 1) * N + n] += s1; H[(m4 * 4 + 2) * N + n] += s2; H[(m4 * 4 + 3) * N + n] += s3;
}

HD inline void gla_loga_body(long gid, const P& p) {
    const long t = gid / 192; const int c = (int)(gid % 192);
    const float* lr = p.PROJ + t * DPROJ + C_LR; float s = p.b_lr[c];
    for (int r = 0; r < GLR; ++r) s += lr[r] * p.w_lr2[r * 192 + c];
    p.BC[t * 192 + c] = logsigf_(s) / 16.0f;
}
HD inline void gla_cumsum_body(long gid, const P& p) {
    const long ch = gid / 192; const int c = (int)(gid % 192);
    float* b = p.BC + ch * GC * 192 + c; float s = 0.f;
    for (int i = 0; i < GC; ++i) { s += b[i * 192]; b[i * 192] = s; }
}
HD inline void gla_kv_body(long gid, const P& p) {
    const int v = (int)(gid % GDV); long r = gid / GDV; const int d = (int)(r % GDK); r /= GDK; const int h = (int)(r % GH); const long ch = r / GH;
    const long t0 = ch * GC; const int cd = h * GDK + d;
    const float bl = p.BC[(t0 + GC - 1) * 192 + cd]; float s = 0.f;
    for (int c = 0; c < GC; ++c) {
        const long t = t0 + c;
        s += p.PROJ[t * DPROJ + C_GK + cd] * expf(bl - p.BC[t * 192 + cd]) * p.PROJ[t * DPROJ + C_GV + h * GDV + v];
    }
    p.KV[gid] = s;
    if (v == 0) p.DEC[(ch * GH + h) * GDK + d] = expf(bl);
}
HD inline void gla_scan_body(long gid, const P& p) {
    const int v = (int)(gid % GDV); long r = gid / GDV; const int d = (int)(r % GDK); r /= GDK; const int h = (int)(r % GH); const int b = (int)(r / GH);
    const int n = p.S / GC; float st = 0.f;
    for (int i = 0; i < n; ++i) {
        const long ch = (long)b * n + i; const long idx = ((ch * GH + h) * GDK + d) * GDV + v;
        p.ST[idx] = st; st = p.DEC[(ch * GH + h) * GDK + d] * st + p.KV[idx];
    }
}
HD inline void gla_att_body(long gid, const P& p) {
    const int s = (int)(gid % GC); long r = gid / GC; const int c = (int)(r % GC); r /= GC; const int h = (int)(r % GH); const long ch = r / GH;
    float a = 0.f;
    if (s <= c) {
        const long tc = ch * GC + c, ts = ch * GC + s; const float sc = 1.0f / sqrtf((float)GDK);
        for (int d = 0; d < GDK; ++d) {
            const int cd = h * GDK + d;
            const float qd = p.PROJ[tc * DPROJ + C_GQ + cd] * sc * expf(p.BC[tc * 192 + cd]);
            const float ki = p.PROJ[ts * DPROJ + C_GK + cd] * expf(-p.BC[ts * 192 + cd]);
            a += qd * ki;
        }
    }
    p.ATT[gid] = a;
}
HD inline void gla_o_body(long gid, const P& p) {
    const int v = (int)(gid % GDV); long r = gid / GDV; const int h = (int)(r % GH); const long t = r / GH;
    const long ch = t / GC; const int c = (int)(t % GC); const float sc = 1.0f / sqrtf((float)GDK);
    const float* att = p.ATT + ((ch * GH + h) * GC + c) * GC; float o = 0.f;
    for (int s = 0; s <= c; ++s) o += att[s] * p.PROJ[(ch * GC + s) * DPROJ + C_GV + h * GDV + v];
    const float* st = p.ST + ((ch * GH + h) * GDK) * GDV + v;
    for (int d = 0; d < GDK; ++d) { const int cd = h * GDK + d; o += p.PROJ[t * DPROJ + C_GQ + cd] * sc * expf(p.BC[t * 192 + cd]) * st[d * GDV]; }
    p.O[t * 384 + h * GDV + v] = o;
}
HD inline void gla_norm_body(long gid, const P& p) {
    const long t = gid / 384; const int j = (int)(gid % 384); const int h = j / GDV, v = j % GDV;
    const float* o = p.O + t * 384 + h * GDV; float s = 0.f;
    for (int i = 0; i < GDV; ++i) s += o[i] * o[i];
    const float r = 1.0f / sqrtf(s / GDV + 1e-6f);
    p.MIX[t * D + j] = o[v] * r * p.gnorm_g[v] * siluf_(p.PROJ[t * DPROJ + C_GO + j]);
}

HD inline void sb_body(long gid, const P& p) {
    const int tpos = (int)(gid % p.S); long r = gid / p.S; const int h = (int)(r % SH); const int b = (int)(r / SH);
    const long trow = (long)b * p.S + tpos;
    float q[SD], acc[SD];
#pragma unroll
    for (int d = 0; d < SD; ++d) { q[d] = p.PROJ[trow * DPROJ + C_SQ + h * SD + d] * 0.125f; acc[d] = 0.f; }
    float suffix = 0.f;
    for (int s = tpos - 1; s >= 0; --s) {
        const float* kr = p.PROJ + ((long)b * p.S + s) * DPROJ + C_SK + h * SD;
        const float* vr = p.PROJ + ((long)b * p.S + s) * DPROJ + C_SV + h * SD;
        float z = 0.f;
#pragma unroll
        for (int d = 0; d < SD; ++d) z += q[d] * kr[d];
        const float a = expf(logsigf_(z) + suffix);
#pragma unroll
        for (int d = 0; d < SD; ++d) acc[d] += a * vr[d];
        suffix += logsigf_(-z);
        if (suffix < -105.0f) break;
    }
#pragma unroll
    for (int d = 0; d < SD; ++d) p.MIX[trow * D + 384 + h * SD + d] = acc[d];
}

HD inline void pool_body(long gid, const P& p) {
    const long t = gid / PW; const int j = (int)(gid % PW); const int gi = j / PGC, dd = j % PGC;
    const int tpos = (int)(t % p.S); const int w = 2 << gi; const int cnt = (tpos + 1 < w) ? tpos + 1 : w;
    float y = 0.f;
    for (int c = 0; c < PGC; ++c) {
        const int col = C_PU + gi * PGC + c; float ws = 0.f;
        for (int i = 0; i < cnt; ++i) ws += p.PROJ[(t - i) * DPROJ + col];
        const float pooled = ws / (float)cnt - p.PROJ[t * DPROJ + col];
        y += pooled * p.pool_w[(gi * PGC + c) * PGC + dd];
    }
    p.MIX[t * D + 768 + j] = y * p.pool_scale[j];
}

HD inline void router_logit_body(long gid, const P& p) {
    const long t = gid / 36; const int j = (int)(gid % 36);
    const float* hr = p.H + t * D; float s = 0.f;
    if (j < 4) { for (int k = 0; k < D; ++k) s += hr[k] * p.norm2_g[k] * p.rg_w[k * 4 + j]; s = s * p.RSTD[t] + p.rg_b[j]; }
    else { const int e = j - 4; for (int k = 0; k < D; ++k) s += hr[k] * p.norm2_g[k] * p.re_w[k * 32 + e]; s = s * p.RSTD[t] + p.re_b[e]; }
    p.LOG[gid] = s;
}
HD inline void router_pick_body(long t, const P& p) {
    const float* lg = p.LOG + t * 36;
    int gi = 0; float gm = lg[0];
    for (int j = 1; j < 4; ++j) if (lg[j] > gm) { gm = lg[j]; gi = j; }
    float gs = 0.f; for (int j = 0; j < 4; ++j) gs += expf(lg[j] - gm);
    const float gw = 1.0f / gs;
    const float* el = lg + 4 + gi * EPG;
    int i0 = 0; float m0 = el[0];
    for (int j = 1; j < EPG; ++j) if (el[j] > m0) { m0 = el[j]; i0 = j; }
    int i1 = -1; float m1 = -INFINITY;
    for (int j = 0; j < EPG; ++j) if (j != i0 && el[j] > m1) { m1 = el[j]; i1 = j; }
    const float e1 = expf(m1 - m0); const float w0 = 1.0f / (1.0f + e1), w1 = e1 / (1.0f + e1);
    p.EID[t * 2 + 0] = gi * EPG + i0; p.EID[t * 2 + 1] = gi * EPG + i1;
    p.EW[t * 2 + 0] = w0 * gw; p.EW[t * 2 + 1] = w1 * gw;
}
HD inline void moe_hid_body(long gid, const P& p) {
    const int f = (int)(gid % DE); long r = gid / DE; const int kk = (int)(r % 2); const long t = r / 2;
    const int e = p.EID[t * 2 + kk]; const float* hr = p.H + t * D;
    const float* wg = p.wg + (long)e * D * DE + f; const float* wu = p.wu + (long)e * D * DE + f;
    float a = 0.f, b = 0.f;
    for (int k = 0; k < D; ++k) { const float x = hr[k] * p.norm2_g[k]; a += x * wg[(long)k * DE]; b += x * wu[(long)k * DE]; }
    a *= p.RSTD[t]; b *= p.RSTD[t];
    p.HID[gid] = siluf_(a) * b * p.EW[t * 2 + kk];
}
HD inline void moe_down_body(long gid, const P& p) {
    const long t = gid / D; const int d = (int)(gid % D); float y = 0.f;
    for (int kk = 0; kk < 2; ++kk) {
        const int e = p.EID[t * 2 + kk]; const float* hid = p.HID + (t * 2 + kk) * DE; const float* wd = p.wd + (long)e * DE * D + d;
        for (int f = 0; f < DE; ++f) y += hid[f] * wd[(long)f * D];
    }
    p.H2[gid] = p.H[gid] + y;
}
HD inline void ple_body(long gid, const P& p, const float* pl) {
    const long t = gid / D; const int n = (int)(gid % D); const float* hr = p.H2 + t * D;
    float s = 0.f; for (int k = 0; k < D; ++k) s += hr[k] * p.ple_g[k] * p.ple_w[(long)k * D + n];
    s = s * p.RSTD[t] + p.ple_b[n];
    float e = 0.f; const float* pr = pl + t * PLE; for (int j = 0; j < PLE; ++j) e += pr[j] * p.ple_p[(long)j * D + n];
    p.H[gid] = hr[n] + sigmoidf_(s) * e;
}
HD inline void final_body(long gid, const P& p) { const long t = gid / D; const int n = (int)(gid % D); p.out[gid] = p.H[gid] * p.RSTD[t] * p.final_g[n]; }
}

namespace nv {
enum { K_COPY, K_RSTD_H, K_RSTD_H2, K_INPROJ, K_LOGA, K_CUMSUM, K_KV, K_SCAN, K_ATT, K_GO, K_GNORM, K_SB, K_POOL, K_OUTPROJ,
       K_RLOGIT, K_RPICK, K_MHID, K_MDOWN, K_PLE, K_FINAL };
template <int ID> HD inline void dispatch(long gid, const P& p) {
    if constexpr (ID == K_COPY) copy_body(gid, p.x, p.H);
    else if constexpr (ID == K_RSTD_H) rstd_body(gid, p.H, p.RSTD);
    else if constexpr (ID == K_RSTD_H2) rstd_body(gid, p.H2, p.RSTD);
    else if constexpr (ID == K_INPROJ) gemm_rs_body(gid, p.H, p.RSTD, p.norm1_g, p.w_in, p.PROJ, DPROJ, D);
    else if constexpr (ID == K_LOGA) gla_loga_body(gid, p);
    else if constexpr (ID == K_CUMSUM) gla_cumsum_body(gid, p);
    else if constexpr (ID == K_KV) gla_kv_body(gid, p);
    else if constexpr (ID == K_SCAN) gla_scan_body(gid, p);
    else if constexpr (ID == K_ATT) gla_att_body(gid, p);
    else if constexpr (ID == K_GO) gla_o_body(gid, p);
    else if constexpr (ID == K_GNORM) gla_norm_body(gid, p);
    else if constexpr (ID == K_SB) sb_body(gid, p);
    else if constexpr (ID == K_POOL) pool_body(gid, p);
    else if constexpr (ID == K_OUTPROJ) gemm_res_body(gid, p.MIX, p.w_out, p.H, D, D);
    else if constexpr (ID == K_RLOGIT) router_logit_body(gid, p);
    else if constexpr (ID == K_RPICK) router_pick_body(gid, p);
    else if constexpr (ID == K_MHID) moe_hid_body(gid, p);
    else if constexpr (ID == K_MDOWN) moe_down_body(gid, p);
    else if constexpr (ID == K_PLE) ple_body(gid, p, p.pl);
    else if constexpr (ID == K_FINAL) final_body(gid, p);
}
inline size_t carve(P& p, float* ws, float* outbuf) {
    size_t o = 0; const size_t T = p.T; const size_t nch = T / GC;
    auto take = [&](size_t n) { float* r = ws ? ws + o : nullptr; o += (n + 63) & ~(size_t)63; return r; };
    p.H = take(T * D); p.RSTD = take(T); p.PROJ = take(T * DPROJ); p.BC = take(T * 192);
    p.KV = take(nch * GH * GDK * GDV); p.DEC = take(nch * GH * GDK); p.ST = take(nch * GH * GDK * GDV); p.ATT = take(nch * GH * GC * GC);
    p.O = take(T * 384);
    p.MIX = outbuf; p.H2 = outbuf;
    float* q = p.PROJ; p.LOG = q; q += T * 36; p.EW = q; q += T * 2; p.EID = (int*)q; q += T * 2; p.HID = q;
    return o;
}
template <class Exec> inline void forward(P p, const float* const* in, Exec& ex) {
    const long T = p.T; const long nch = T / GC;
    p.x = in[0];
    ex.template run<K_COPY>(T * D, p);
    for (int l = 0; l < DEPTH; ++l) {
        p.pl = in[1] + (size_t)l * T * PLE;
        p.norm1_g = in[2] + (size_t)l * D; p.w_in = in[3] + (size_t)l * D * DPROJ; p.w_lr2 = in[4] + (size_t)l * GLR * 192; p.b_lr = in[5] + (size_t)l * 192;
        p.gnorm_g = in[6] + (size_t)l * GDV; p.pool_w = in[7] + (size_t)l * 4 * PGC * PGC; p.pool_scale = in[8] + (size_t)l * PW; p.w_out = in[9] + (size_t)l * D * D;
        p.norm2_g = in[10] + (size_t)l * D; p.rg_w = in[11] + (size_t)l * D * 4; p.rg_b = in[12] + (size_t)l * 4; p.re_w = in[13] + (size_t)l * D * 32; p.re_b = in[14] + (size_t)l * 32;
        p.wg = in[15] + (size_t)l * NE * D * DE; p.wu = in[16] + (size_t)l * NE * D * DE; p.wd = in[17] + (size_t)l * NE * DE * D;
        p.ple_g = in[18] + (size_t)l * D; p.ple_w = in[19] + (size_t)l * D * D; p.ple_b = in[20] + (size_t)l * D; p.ple_p = in[21] + (size_t)l * PLE * D;
        ex.template run<K_RSTD_H>(T, p);
        ex.template run<K_INPROJ>(T / 4 * DPROJ, p);
        ex.template run<K_LOGA>(T * 192, p);
        ex.template run<K_CUMSUM>(nch * 192, p);
        ex.template run<K_KV>(nch * GH * GDK * GDV, p);
        ex.template run<K_SCAN>((long)p.B * GH * GDK * GDV, p);
        ex.template run<K_ATT>(nch * GH * GC * GC, p);
        ex.template run<K_GO>(T * GH * GDV, p);
        ex.template run<K_GNORM>(T * 384, p);
        ex.template run<K_SB>((long)p.B * SH * p.S, p);
        ex.template run<K_POOL>(T * PW, p);
        ex.template run<K_OUTPROJ>(T / 4 * D, p);
        ex.template run<K_RSTD_H>(T, p);
        ex.template run<K_RLOGIT>(T * 36, p);
        ex.template run<K_RPICK>(T, p);
        ex.template run<K_MHID>(T * 2 * DE, p);
        ex.template run<K_MDOWN>(T * D, p);
        ex.template run<K_RSTD_H2>(T, p);
        ex.template run<K_PLE>(T * D, p);
    }
    p.final_g = in[22];
    ex.template run<K_RSTD_H>(T, p);
    ex.template run<K_FINAL>(T * D, p);
}
}

template <int ID> __global__ void __launch_bounds__(256) nk(long n, nv::P p) {
    const long gid = (long)blockIdx.x * 256 + threadIdx.x;
    if (gid < n) nv::dispatch<ID>(gid, p);
}
struct GpuExec { hipStream_t st; template <int ID> void run(long n, const nv::P& p) {
    hipLaunchKernelGGL((nk<ID>), dim3((unsigned)((n + 255) / 256)), dim3(256), 0, st, n, p); } };

extern "C" void kernel_launch(void* const* d_in, const int* in_sizes, int n_in, void* d_out, int out_size, void* d_ws, size_t ws_size, hipStream_t stream) {
    nv::P p{}; p.B = 4; p.S = 4096; p.T = 4 * 4096;
    p.out = (float*)d_out;
    const size_t need = nv::carve(p, (float*)d_ws, (float*)d_out) * sizeof(float);
    if (need > ws_size) { fprintf(stderr, "kernel_launch: workspace too small: need %zu have %zu\n", need, ws_size); return; }
    const float* in[23]; for (int i = 0; i < 23; ++i) in[i] = (const float*)d_in[i];
    GpuExec ex{stream};
    nv::forward(p, in, ex);
}
```

```cpp
#include <hip/hip_runtime.h>
#include <cstdio>
#include <cstdint>
#include <math.h>
#define LAS __attribute__((address_space(3)))
namespace gp {
typedef unsigned short bf16_t;
typedef short bf16x8 __attribute__((ext_vector_type(8)));
typedef float f32x4 __attribute__((ext_vector_type(4)));
typedef unsigned u32x4 __attribute__((ext_vector_type(4)));
typedef unsigned u32x2 __attribute__((ext_vector_type(2)));
constexpr int BM = 256, BK = 64, HALF = 128, HTB = HALF * BK * 2, STAGE_BYTES = 8 * HTB;

__host__ __device__ __forceinline__ int lds_byte(int r, int c) { const int st = (r >> 4) * 2 + (c >> 5), rr = r & 15, cc = c & 31, ob = rr * 64 + cc * 2; return st * 1024 + (ob ^ (((ob >> 9) & 1) << 5)); }
__host__ __device__ __forceinline__ void stage_rc(int b, int& R, int& C) { const int st = b / 1024, sb = b % 1024, swz = sb ^ (((sb >> 9) & 1) << 5); R = (st >> 1) * 16 + swz / 64; C = (st & 1) * 32 + (swz % 64) / 2; }
__host__ __device__ __forceinline__ int perm32(int rho) { const int n = rho >> 4, i = rho & 15; return 8 * (i >> 2) + 4 * n + (i & 3); }
__device__ __forceinline__ unsigned cvt_pk_bf16(float lo, float hi) { typedef float f2_ __attribute__((ext_vector_type(2))); typedef __bf16 b2_ __attribute__((ext_vector_type(2))); const f2_ v_ = {lo, hi}; return __builtin_bit_cast(unsigned, __builtin_convertvector(v_, b2_)); }

__device__ __forceinline__ const char* rfl_ptr(const char* p) {
    const unsigned long long v = (unsigned long long)p; const unsigned lo = __builtin_amdgcn_readfirstlane((unsigned)v), hi = __builtin_amdgcn_readfirstlane((unsigned)(v >> 32)); return (const char*)(((unsigned long long)hi << 32) | lo); }
struct Unit { int pm, pn; const char* aB; const char* bB; int nt; const int* rl; int aux; };

template <class Epi, class Sched>
__device__ __forceinline__ void gemm_phase(LAS unsigned char* lds, const Sched& S, const Epi& E, const int lda  , const int ldb  , const int wid  ) {
    unsigned m_ = ~0u; asm volatile("" : "+s"(m_)); const int lane0 = (int)__builtin_amdgcn_mbcnt_hi(m_, __builtin_amdgcn_mbcnt_lo(m_, 0u));
    const int tid = wid * 64 + lane0, lane = tid & 63, wr = wid >> 2, wc = wid & 3, fr = lane & 15, fq = lane >> 4;
    unsigned voffA[2], voffB[2];
#pragma unroll
    for (int i = 0; i < 2; ++i) { int R, C; stage_rc(tid * 16 + i * 8192, R, C); const int Rb = Epi::PERM ? ((R & ~31) + perm32(R & 31)) : R; voffB[i] = (unsigned)(Rb * ldb + C) * 2u;
        voffA[i] = Sched::GATHER ? (unsigned)(R | (C << 16)) : (unsigned)(R * lda + C) * 2u; }
    const size_t hstepA = Sched::GATHER ? 0 : (size_t)HALF * lda * 2;
    const size_t kstep = (size_t)(BK * 2);
    const size_t hstepB = (size_t)HALF * ldb * 2;
    const unsigned ldsw = (unsigned)wid * 1024u;
    const int aoff = lds_byte(wr * 64 + fr, fq * 8), boff = lds_byte(wc * 32 + fr, fq * 8);
    unsigned ac[2], an[2];
#define GP_AOFF(dst, u) do { if constexpr (Sched::GATHER) { _Pragma("unroll") for (int _h = 0; _h < 2; ++_h) \
        dst[_h] = S.arow((u), _h * HALF + (int)(voffA[0] & 0xffffu)) | (S.arow((u), _h * HALF + (int)(voffA[1] & 0xffffu)) << 16); } } while (0)
#define GP_STAGE_A(bufoff, kp, h, which) do { if constexpr (Sched::GATHER) { const unsigned _p = ((which) && last) ? an[h] : ac[h]; \
        const unsigned _o0 = (_p & 0xffffu) * (unsigned)(lda * 2) + (voffA[0] >> 16) * 2u, _o1 = (_p >> 16) * (unsigned)(lda * 2) + (voffA[1] >> 16) * 2u; GP_STAGE(bufoff, kp, _o0, _o1); } \
        else GP_STAGE(bufoff, (kp) + (h) * hstepA, voffA[0], voffA[1]); } while (0)
#define GP_SA(b, h) (((b) * 2 + (h)) * HTB)
#define GP_SB(b, h) ((4 + (b) * 2 + (h)) * HTB)
#define GP_STAGE(bufoff, gbase, o0, o1) do { \
        __builtin_amdgcn_global_load_lds((const unsigned*)((const char*)(gbase) + (o0)), (LAS unsigned*)(lds + (bufoff) + ldsw), 16, 0, 0); \
        __builtin_amdgcn_global_load_lds((const unsigned*)((const char*)(gbase) + (o1)), (LAS unsigned*)(lds + (bufoff) + ldsw + 8192), 16, 0, 0); } while (0)
#define GP_LDA(dst, b, h) do { _Pragma("unroll") for (int m = 0; m < 4; ++m) _Pragma("unroll") for (int k = 0; k < 2; ++k) dst[m][k] = *(const LAS bf16x8*)(lds + GP_SA(b, h) + aoff + m * 2048 + k * 1024); } while (0)
#define GP_LDB(dst, b, h) do { _Pragma("unroll") for (int n = 0; n < 2; ++n) _Pragma("unroll") for (int k = 0; k < 2; ++k) dst[n][k] = *(const LAS bf16x8*)(lds + GP_SB(b, h) + boff + n * 2048 + k * 1024); } while (0)
#define GP_MMA(ai, bj, At, Bt) do { __builtin_amdgcn_s_setprio(1); _Pragma("unroll") for (int m = 0; m < 4; ++m) _Pragma("unroll") for (int n = 0; n < 2; ++n) _Pragma("unroll") for (int k = 0; k < 2; ++k) \
        acc[ai][bj][m][n] = __builtin_amdgcn_mfma_f32_16x16x32_bf16(Bt[n][k], At[m][k], acc[ai][bj][m][n], 0, 0, 0); __builtin_amdgcn_s_setprio(0); } while (0)
#define GP_WAIT_V(n) asm volatile("s_waitcnt vmcnt(" #n ")" ::: "memory")
#define GP_WAIT_L(n) asm volatile("s_waitcnt lgkmcnt(" #n ")" ::: "memory")
#define GP_BAR __builtin_amdgcn_s_barrier()
#define GP_SCHED __builtin_amdgcn_sched_barrier(0)
    Unit cur, nxt; int ui = 0;
    if (!S.next(0, cur)) return;
    f32x4 acc[2][2][4][2];
#pragma unroll
    for (int a = 0; a < 2; ++a)
#pragma unroll
        for (int b = 0; b < 2; ++b)
#pragma unroll
            for (int m = 0; m < 4; ++m)
#pragma unroll
                for (int n = 0; n < 2; ++n) acc[a][b][m][n] = (f32x4){0.f, 0.f, 0.f, 0.f};
    bf16x8 At[4][2], B0[2][2], B1[2][2];
    const char* cA = rfl_ptr(cur.aB); const char* cB = rfl_ptr(cur.bB);
    GP_AOFF(ac, cur);
    GP_STAGE(GP_SB(0, 0), cB, voffB[0], voffB[1]); GP_STAGE(GP_SB(0, 1), cB + hstepB, voffB[0], voffB[1]); { constexpr bool last = false; GP_STAGE_A(GP_SA(0, 0), cA, 0, 0); GP_STAGE_A(GP_SA(0, 1), cA, 1, 0); }
    if (wr == 1) GP_BAR;
    GP_WAIT_V(2); GP_BAR;
    GP_STAGE(GP_SB(1, 0), cB + kstep, voffB[0], voffB[1]); { constexpr bool last = false; GP_STAGE_A(GP_SA(1, 0), cA + kstep, 0, 0); } GP_STAGE(GP_SB(1, 1), cB + hstepB + kstep, voffB[0], voffB[1]);
    GP_WAIT_V(6); GP_BAR;
    for (;;) {
        const bool has_next = S.next(ui + 1, nxt);
        const char* nA = has_next ? rfl_ptr(nxt.aB) : cA; const char* nB = has_next ? rfl_ptr(nxt.bB) : cB;
        if constexpr (Sched::GATHER) { if (has_next) { GP_AOFF(an, nxt); } else {
            an[0] = ac[0]; an[1] = ac[1]; } }
        const int nt = cur.nt;
        const bool hi = !(Sched::SKIPHI && cur.aux <= 128);
        for (int t = 0; t < nt; t += 2) {
            const bool last = (t == nt - 2);
            const char* a1 = cA + (size_t)(t + 1) * kstep;
            const char* a2 = last ? nA : cA + (size_t)(t + 2) * kstep; const char* b2 = last ? nB : cB + (size_t)(t + 2) * kstep;
            const char* a3 = a2 + kstep; const char* b3 = b2 + kstep;
            GP_LDB(B0, 0, 0); GP_LDB(B1, 0, 1); GP_SCHED; GP_LDA(At, 0, 0); GP_STAGE_A(GP_SA(1, 1), a1, 1, 0);
            GP_WAIT_V(8); GP_WAIT_L(0); GP_BAR; GP_MMA(0, 0, At, B0); GP_MMA(0, 1, At, B1); GP_BAR; GP_SCHED;
            if (hi) GP_LDA(At, 0, 1); GP_STAGE(GP_SB(0, 0), b2, voffB[0], voffB[1]); GP_STAGE(GP_SB(0, 1), b2 + hstepB, voffB[0], voffB[1]); GP_STAGE_A(GP_SA(0, 0), a2, 0, 1);
            GP_WAIT_V(8); GP_WAIT_L(0); GP_BAR; if (hi) { GP_MMA(1, 0, At, B0); GP_MMA(1, 1, At, B1); } GP_BAR; GP_SCHED;
            GP_LDB(B0, 1, 0); GP_LDB(B1, 1, 1); GP_SCHED; GP_LDA(At, 1, 0); GP_STAGE_A(GP_SA(0, 1), a2, 1, 1);
            GP_WAIT_V(8); GP_WAIT_L(0); GP_BAR; GP_MMA(0, 0, At, B0); GP_MMA(0, 1, At, B1); GP_BAR; GP_SCHED;
            if (hi) GP_LDA(At, 1, 1); GP_STAGE(GP_SB(1, 0), b3, voffB[0], voffB[1]); GP_STAGE(GP_SB(1, 1), b3 + hstepB, voffB[0], voffB[1]); GP_STAGE_A(GP_SA(1, 0), a3, 0, 1);
            GP_WAIT_V(8); GP_WAIT_L(0); GP_BAR; if (hi) { GP_MMA(1, 0, At, B0); GP_MMA(1, 1, At, B1); } GP_BAR; GP_SCHED;
        }
        if (wr == 0) GP_BAR;
        { unsigned m2 = ~0u; asm volatile("" : "+s"(m2)); const int l2 = (int)__builtin_amdgcn_mbcnt_hi(m2, __builtin_amdgcn_mbcnt_lo(m2, 0u));
          E(acc, cur, wr, wc, l2 & 15, l2 >> 4); }
        if constexpr (Sched::HOOKS) S.done(cur);
        if (!has_next) break;
#pragma unroll
        for (int a = 0; a < 2; ++a)
#pragma unroll
            for (int b = 0; b < 2; ++b)
#pragma unroll
                for (int m = 0; m < 4; ++m)
#pragma unroll
                    for (int n = 0; n < 2; ++n) acc[a][b][m][n] = (f32x4){0.f, 0.f, 0.f, 0.f};
        cur = nxt; cA = nA; cB = nB; ++ui;
        if constexpr (Sched::GATHER) { ac[0] = an[0]; ac[1] = an[1]; }
        if (wr == 1) GP_BAR;
    }
    GP_WAIT_V(0);
    GP_BAR;
#undef GP_AOFF
#undef GP_STAGE_A
#undef GP_SA
#undef GP_SB
#undef GP_STAGE
#undef GP_LDA
#undef GP_LDB
#undef GP_MMA
#undef GP_WAIT_V
#undef GP_WAIT_L
#undef GP_BAR
#undef GP_SCHED
}
}
namespace sb {
typedef short bf16x8 __attribute__((ext_vector_type(8)));
typedef short s16x4 __attribute__((ext_vector_type(4)));
typedef float f32x16 __attribute__((ext_vector_type(16)));
typedef unsigned u32x4 __attribute__((ext_vector_type(4)));
typedef unsigned u32x2 __attribute__((ext_vector_type(2)));
constexpr int VS = 192;
constexpr int VT_BYTES = 64 * VS;
#define SB_MFMA(a, b, c) __builtin_amdgcn_mfma_f32_32x32x16_bf16((a), (b), (c), 0, 0, 0)

__device__ __forceinline__ unsigned cvt2(float lo, float hi) { typedef float f2_ __attribute__((ext_vector_type(2))); typedef __bf16 b2_ __attribute__((ext_vector_type(2))); const f2_ v_ = {lo, hi}; return __builtin_bit_cast(unsigned, __builtin_convertvector(v_, b2_)); }
__device__ __forceinline__ bf16x8 pack_step(const float (&x)[16], int s) {
    u32x4 p; p[0] = cvt2(x[8 * s], x[8 * s + 1]); p[1] = cvt2(x[8 * s + 2], x[8 * s + 3]); p[2] = cvt2(x[8 * s + 4], x[8 * s + 5]); p[3] = cvt2(x[8 * s + 6], x[8 * s + 7]);
    return __builtin_bit_cast(bf16x8, p);
}
__device__ __forceinline__ void tr_read4(s16x4& r0, s16x4& r1, s16x4& r2, s16x4& r3, unsigned a0, unsigned a1, unsigned a2, unsigned a3) {
    asm volatile("ds_read_b64_tr_b16 %0, %4\n\tds_read_b64_tr_b16 %1, %5\n\tds_read_b64_tr_b16 %2, %6\n\tds_read_b64_tr_b16 %3, %7\n\ts_waitcnt lgkmcnt(0)"
                 : "=&v"(r0), "=&v"(r1), "=&v"(r2), "=&v"(r3) : "v"(a0), "v"(a1), "v"(a2), "v"(a3) : "memory");
}
__device__ __forceinline__ float partner32(float x, int hh) {
    const auto r = __builtin_amdgcn_permlane32_swap(__float_as_uint(x), __float_as_uint(x), false, false);
    return __uint_as_float(hh ? r[0] : r[1]);
}

template <bool MASK, int NKB>
__device__ __forceinline__ void sb_tile(const unsigned short* PROJ, const size_t krow0, const int h, const int r, const int hh, const int vrow, const int vchunk, LAS unsigned char* vtp, const unsigned tra,
                                        const bf16x8 (&qf)[4], float (&o0)[16], float (&o1)[16], float& carry, const int tq) {
    constexpr int LDP = 2816, CK = 1552, CV = 1936;
    u32x4 vreg[4 * NKB];
#pragma unroll
    for (int i = 0; i < 4 * NKB; ++i) vreg[i] = *(const u32x4*)(PROJ + (krow0 + 8 * i + vrow) * LDP + CV + h * 64 + 8 * vchunk);
    float sv[NKB][16];
    { const unsigned short* kp = PROJ + (krow0 + r) * LDP + CK + h * 64 + 8 * hh;
      bf16x8 kf[NKB][4];
#pragma unroll
      for (int kb = 0; kb < NKB; ++kb)
#pragma unroll
          for (int ks = 0; ks < 4; ++ks) kf[kb][ks] = *(const bf16x8*)(kp + (size_t)32 * kb * LDP + 16 * ks);
#pragma unroll
      for (int kb = 0; kb < NKB; ++kb) { f32x16 s;
#pragma unroll
          for (int i = 0; i < 16; ++i) s[i] = 0.f;
#pragma unroll
          for (int ks = 0; ks < 4; ++ks) s = SB_MFMA(kf[kb][ks], qf[ks], s);
#pragma unroll
          for (int i = 0; i < 16; ++i) sv[kb][i] = s[i]; } }
#pragma unroll
    for (int i = 0; i < 4 * NKB; ++i) *(LAS u32x4*)(vtp + (8 * i + vrow) * VS + 16 * vchunk) = vreg[i];
    float L[NKB][16], M[NKB][16];
#pragma unroll
    for (int kb = 0; kb < NKB; ++kb)
#pragma unroll
        for (int i = 0; i < 16; ++i) { const float z = sv[kb][i];
            const float e = __builtin_amdgcn_exp2f(-__builtin_fabsf(z)); const float lg = __builtin_amdgcn_logf(1.0f + e);
            M[kb][i] = fminf(z, 0.f) - lg; L[kb][i] = M[kb][i] - z;
            if constexpr (MASK) { const int kk = 32 * kb + (i & 3) + 8 * (i >> 2) + 4 * hh; L[kb][i] = (kk < tq) ? L[kb][i] : 0.f; } }
    float G[NKB][4], Gp[NKB][4];
#pragma unroll
    for (int kb = 0; kb < NKB; ++kb)
#pragma unroll
        for (int u = 0; u < 4; ++u) { G[kb][u] = (L[kb][4 * u] + L[kb][4 * u + 1]) + (L[kb][4 * u + 2] + L[kb][4 * u + 3]); Gp[kb][u] = partner32(G[kb][u], hh); }
    float run = carry; float A[NKB][16];
#pragma unroll
    for (int kb = NKB - 1; kb >= 0; --kb)
#pragma unroll
        for (int u = 3; u >= 0; --u) {
            const float off = run + (hh ? 0.f : Gp[kb][u]);
            run += G[kb][u] + Gp[kb][u];
            const float l3 = L[kb][4 * u + 3], l2 = L[kb][4 * u + 2], l1 = L[kb][4 * u + 1];
            const float sf3 = off, sf2 = off + l3, sf1 = sf2 + l2, sf0 = sf1 + l1;
            A[kb][4 * u + 3] = __builtin_amdgcn_exp2f(M[kb][4 * u + 3] + sf3); A[kb][4 * u + 2] = __builtin_amdgcn_exp2f(M[kb][4 * u + 2] + sf2);
            A[kb][4 * u + 1] = __builtin_amdgcn_exp2f(M[kb][4 * u + 1] + sf1); A[kb][4 * u + 0] = __builtin_amdgcn_exp2f(M[kb][4 * u + 0] + sf0);
            if constexpr (MASK) { const int kk0 = 32 * kb + 8 * u + 4 * hh;
                A[kb][4 * u + 3] = (kk0 + 3 < tq) ? A[kb][4 * u + 3] : 0.f; A[kb][4 * u + 2] = (kk0 + 2 < tq) ? A[kb][4 * u + 2] : 0.f;
                A[kb][4 * u + 1] = (kk0 + 1 < tq) ? A[kb][4 * u + 1] : 0.f; A[kb][4 * u + 0] = (kk0 + 0 < tq) ? A[kb][4 * u + 0] : 0.f; }
        }
    carry = run;
    asm volatile("s_waitcnt lgkmcnt(0)" ::: "memory");
#pragma unroll
    for (int kb = 0; kb < NKB; ++kb)
#pragma unroll
        for (int s = 0; s < 2; ++s) {
            const bf16x8 pb = pack_step(A[kb], s);
            const unsigned a_lo = tra + (unsigned)((32 * kb + 16 * s + 4 * hh) * VS), a_hi = a_lo + 8 * VS;
            s16x4 l0, h0, l1, h1;
            tr_read4(l0, h0, l1, h1, a_lo, a_hi, a_lo + 64, a_hi + 64);
            const bf16x8 va0 = __builtin_shufflevector(l0, h0, 0, 1, 2, 3, 4, 5, 6, 7), va1 = __builtin_shufflevector(l1, h1, 0, 1, 2, 3, 4, 5, 6, 7);
            f32x16 t0, t1;
#pragma unroll
            for (int i = 0; i < 16; ++i) { t0[i] = o0[i]; t1[i] = o1[i]; }
            t0 = SB_MFMA(va0, pb, t0); t1 = SB_MFMA(va1, pb, t1);
#pragma unroll
            for (int i = 0; i < 16; ++i) { o0[i] = t0[i]; o1[i] = t1[i]; }
        }
}

__device__ __forceinline__ void sb_phase(LAS unsigned char* lds, const unsigned short* PROJ, unsigned short* MIX, const int vcu, const int G, const int wave, const int lane) {
    constexpr int LDP = 2816, CQ = 1168, CK = 1552, CV = 1936, S = 4096;
    const int r = lane & 31, hh = lane >> 5;
    const unsigned vt = (unsigned)(wave * VT_BYTES);
    LAS unsigned char* vtp = lds + wave * VT_BYTES;
    const unsigned tra = vt + (unsigned)(((lane & 15) >> 2) * VS + (((lane >> 4) & 1) * 16 + (lane & 3) * 4) * 2);
    const int vrow = lane >> 3, vchunk = lane & 7;
    const int ipc = (3072 + G - 1) / G;
    for (int li = wave; li < ipc; li += 8) {
        const int wi = vcu * ipc + li; if (wi >= 3072) break;
        const int w4 = wi & 3, qb = (wi >> 2) & 31, bh = wi >> 7, h = bh % 6, b = bh / 6;
        const int q0 = qb * 128 + w4 * 32;
        const size_t rowbase = (size_t)b * S;
        bf16x8 qf[4];
        {
            const unsigned short* qp = PROJ + (rowbase + q0 + r) * LDP + CQ + h * 64 + 8 * hh;
#pragma unroll
            for (int ks = 0; ks < 4; ++ks) { const u32x4 raw = *(const u32x4*)(qp + 16 * ks); u32x4 o;
#pragma unroll
                for (int e = 0; e < 4; ++e) { const float lo = __uint_as_float(raw[e] << 16) * 0.18033688f, hi = __uint_as_float(raw[e] & 0xffff0000u) * 0.18033688f;
                    o[e] = cvt2(lo, hi); }
                qf[ks] = __builtin_bit_cast(bf16x8, o); }
        }
        float o0[16], o1[16];
#pragma unroll
        for (int i = 0; i < 16; ++i) { o0[i] = 0.f; o1[i] = 0.f; }
        float carry = 0.f;
        const int trel0 = q0 + r;
        {
            const int j0 = q0 >> 6; const size_t krow0 = rowbase + (size_t)j0 * 64; const int tq = trel0 - j0 * 64;
            if ((q0 & 63) == 0) sb_tile<true, 1>(PROJ, krow0, h, r, hh, vrow, vchunk, vtp, tra, qf, o0, o1, carry, tq);
            else sb_tile<true, 2>(PROJ, krow0, h, r, hh, vrow, vchunk, vtp, tra, qf, o0, o1, carry, tq);
            for (int j = j0 - 1; j >= 0; --j) {
                if (__builtin_amdgcn_ballot_w64(carry > -135.0f) == 0ull) break;
                sb_tile<false, 2>(PROJ, rowbase + (size_t)j * 64, h, r, hh, vrow, vchunk, vtp, tra, qf, o0, o1, carry, 64);
            }
        }
        unsigned short* op = MIX + (rowbase + q0 + r) * 1024 + 384 + h * 64 + 4 * hh;
#pragma unroll
        for (int u = 0; u < 4; ++u) {
            u32x2 w0, w1;
            w0.x = cvt2(o0[4 * u], o0[4 * u + 1]); w0.y = cvt2(o0[4 * u + 2], o0[4 * u + 3]);
            w1.x = cvt2(o1[4 * u], o1[4 * u + 1]); w1.y = cvt2(o1[4 * u + 2], o1[4 * u + 3]);
            *(u32x2*)(op + 8 * u) = w0; *(u32x2*)(op + 32 + 8 * u) = w1;
        }
    }
}
#undef SB_MFMA
}
namespace gla {
typedef short bf16x8 __attribute__((ext_vector_type(8)));
typedef short s16x4 __attribute__((ext_vector_type(4)));
typedef float f32x4 __attribute__((ext_vector_type(4)));
typedef float f32x16 __attribute__((ext_vector_type(16)));
typedef unsigned u32x4 __attribute__((ext_vector_type(4)));
typedef unsigned u32x2 __attribute__((ext_vector_type(2)));
constexpr int LDP = 2816, C_GQ = 0, C_GK = 192, C_GV = 384, C_GO = 768, C_LR = 1152, C_PU = 2320;
constexpr int VSG = 784;
constexpr int KOS = 400;
constexpr int PLS = 528;
constexpr int L_Q = 0, L_U = L_Q + 64 * KOS, L_KI = L_U, L_V = 0, L_KO = L_U + 80 * PLS, L_PL = L_KO + 64 * KOS, L_LR = L_PL + 64 * PLS, L_TOT = L_LR + 64 * 16 * 4, L_BL = L_TOT + 768, L_END = L_BL + 768;
static_assert(64 * VSG <= L_KO && L_END <= 147456, "gla LDS map");
__device__ __forceinline__ float bflo(unsigned u) { return __uint_as_float(u << 16); }
__device__ __forceinline__ float bfhi(unsigned u) { return __uint_as_float(u & 0xffff0000u); }
__device__ __forceinline__ float bf1(unsigned short u) { return __uint_as_float((unsigned)u << 16); }
__device__ __forceinline__ unsigned short f2bf1(float f) { unsigned u = __float_as_uint(f); return (unsigned short)((u + 0x7fffu + ((u >> 16) & 1u)) >> 16); }
__device__ __forceinline__ unsigned cvtpk(float lo, float hi) { typedef float f2_ __attribute__((ext_vector_type(2))); typedef __bf16 b2_ __attribute__((ext_vector_type(2))); const f2_ v_ = {lo, hi}; return __builtin_bit_cast(unsigned, __builtin_convertvector(v_, b2_)); }
__device__ __forceinline__ void tr_read2(s16x4& r0, s16x4& r1, unsigned a0, unsigned a1) {
    asm volatile("ds_read_b64_tr_b16 %0, %2\n\tds_read_b64_tr_b16 %1, %3\n\ts_waitcnt lgkmcnt(0)" : "=&v"(r0), "=&v"(r1) : "v"(a0), "v"(a1) : "memory");
}
__device__ __forceinline__ bf16x8 pack_step(const float (&x)[16], int s) {
    u32x4 p; p[0] = cvtpk(x[8 * s], x[8 * s + 1]); p[1] = cvtpk(x[8 * s + 2], x[8 * s + 3]); p[2] = cvtpk(x[8 * s + 4], x[8 * s + 5]); p[3] = cvtpk(x[8 * s + 6], x[8 * s + 7]);
    return __builtin_bit_cast(bf16x8, p);
}
__device__ __forceinline__ float partner32(float x, int hh) { const auto r = __builtin_amdgcn_permlane32_swap(__float_as_uint(x), __float_as_uint(x), false, false); return __uint_as_float(hh ? r[0] : r[1]); }
__device__ __forceinline__ float logsig(float x) { return fminf(x, 0.f) - __logf(1.0f + __expf(-fabsf(x))); }

__device__ __forceinline__ void stage_v(LAS unsigned char* lds, const unsigned short* PROJ, size_t t0, int tid) {
#pragma unroll
    for (int i = 0; i < 6; ++i) { const int idx = tid + 512 * i, row = idx / 48, ch = idx % 48;
        *(LAS u32x4*)(lds + L_V + row * VSG + 16 * ch) = *(const u32x4*)(PROJ + (t0 + row) * LDP + C_GV + 8 * ch); }
}

struct G1Args { const unsigned short* PROJ; const float* w_lr2; const float* b_lr; unsigned short* QD; unsigned short* KI; float* KVT; float* DEC; const unsigned short* WPLT; const float* pool_scale; unsigned short* MIX; };
template <bool POOL> __device__ __forceinline__ void gla1_phase(LAS unsigned char* lds, const G1Args& a, const int vcu, const int G, const int wave, const int lane_, const int tid_) {
    for (int ch = vcu; ch < 256; ch += G) {
        int lane = lane_; asm volatile("" : "+v"(lane)); const int tid = wave * 64 + lane; (void)tid_;
        const size_t t0 = (size_t)ch * 64; const int tpos0 = (ch & 63) * 64;
        __syncthreads();
        u32x4 vreg[6];
#pragma unroll
        for (int i = 0; i < 6; ++i) { const int idx = tid + 512 * i, row = idx / 48, c8 = idx % 48; vreg[i] = *(const u32x4*)(a.PROJ + (t0 + row) * LDP + C_GV + 8 * c8); }
        const int c = POOL ? tid % 192 : ((tid < 384) ? 32 * (tid >> 6) + (tid & 31) : 0), hf = POOL ? tid / 192 : ((tid >> 5) & 1); float w[16]; float bias = 0.f;
        if (tid < 384) {
#pragma unroll
            for (int r = 0; r < 16; ++r) w[r] = a.w_lr2[r * 192 + c];
            bias = a.b_lr[c]; }
#pragma unroll
        for (int i = 0; i < 3; ++i) { const int idx = tid + 512 * i, row = idx / 24, c8 = idx % 24;
            *(LAS u32x4*)(lds + L_Q + row * KOS + 16 * c8) = *(const u32x4*)(a.PROJ + (t0 + row) * LDP + C_GQ + 8 * c8);
            *(LAS u32x4*)(lds + L_KO + row * KOS + 16 * c8) = *(const u32x4*)(a.PROJ + (t0 + row) * LDP + C_GK + 8 * c8); }
        if constexpr (POOL)
#pragma unroll
        for (int i = 0; i < 5; ++i) { const int idx = tid + 512 * i, row = idx / 32, c8 = idx % 32;
            u32x4 v = (u32x4){0u, 0u, 0u, 0u}; if (tpos0 - 16 + row >= 0) v = *(const u32x4*)(a.PROJ + (t0 + row - 16) * LDP + C_PU + 8 * c8);
            *(LAS u32x4*)(lds + L_U + row * PLS + 16 * c8) = v; }
        if (tid < 128) { const int row = tid >> 1, half = tid & 1; const u32x4 raw = *(const u32x4*)(a.PROJ + (t0 + row) * LDP + C_LR + 8 * half);
            LAS float* dst = (LAS float*)(lds + L_LR) + row * 16 + 8 * half;
            dst[0] = bflo(raw.x); dst[1] = bfhi(raw.x); dst[2] = bflo(raw.y); dst[3] = bfhi(raw.y); dst[4] = bflo(raw.z); dst[5] = bfhi(raw.z); dst[6] = bflo(raw.w); dst[7] = bfhi(raw.w); }
        __syncthreads();
        if constexpr (POOL) { const int j = tid & 255, ph = tid >> 8, gi = j >> 6, w = 2 << gi; const LAS unsigned char* up = lds + L_U + 2 * j + (16 + 32 * ph) * PLS;
          const int tp0 = tpos0 + 32 * ph;
          float ws = 0.f;
          for (int i = 1; i <= w; ++i) ws += bf1(*(const LAS unsigned short*)(up - i * PLS));
          LAS unsigned char* pp = lds + L_PL + 32 * ph * PLS + 2 * j;
#pragma unroll 8
          for (int i = 0; i < 32; ++i) { const float u = bf1(*(const LAS unsigned short*)(up + i * PLS));
              ws += u - bf1(*(const LAS unsigned short*)(up + (i - w) * PLS));
              const int tp = tp0 + i; const int cnt = (tp + 1 < w) ? tp + 1 : w;
              *(LAS unsigned short*)(pp + i * PLS) = f2bf1(ws * __builtin_amdgcn_rcpf((float)cnt) - u); } }
        float val[32];
        if (tid < 384) {
            const LAS f32x4* lr = (const LAS f32x4*)(lds + L_LR) + 32 * hf * 4;
#pragma unroll
            for (int i = 0; i < 32; ++i) { float s = bias;
#pragma unroll
                for (int q = 0; q < 4; ++q) { const f32x4 x = lr[4 * i + q]; s += x.x * w[4 * q] + x.y * w[4 * q + 1] + x.z * w[4 * q + 2] + x.w * w[4 * q + 3]; }
                val[i] = logsig(s) * 0.0625f; }
#pragma unroll
            for (int i = 1; i < 32; ++i) val[i] += val[i - 1];
            if constexpr (POOL) { if (hf == 0) ((LAS float*)(lds + L_TOT))[c] = val[31]; }
        }
        float blr = 0.f;
        if constexpr (POOL) {
        __syncthreads();
        if (tid < 384 && hf == 1) { const float t = ((LAS float*)(lds + L_TOT))[c];
#pragma unroll
            for (int i = 0; i < 32; ++i) val[i] += t;
            ((LAS float*)(lds + L_BL))[c] = val[31]; a.DEC[(size_t)ch * 192 + c] = __expf(val[31]); }
        __syncthreads();
        } else if (tid < 384) {
            const float tot = val[31], ptot = partner32(tot, hf);
            if (hf == 1) {
#pragma unroll
                for (int i = 0; i < 32; ++i) val[i] += ptot;
                a.DEC[(size_t)ch * 192 + c] = __expf(val[31]); }
            blr = (hf == 1) ? val[31] : tot + ptot;
        }
        if (tid < 384) { const float bl = POOL ? ((LAS float*)(lds + L_BL))[c] : blr;
            LAS unsigned char* qp = lds + L_Q + 32 * hf * KOS + 2 * c; LAS unsigned char* kp = lds + L_KO + 32 * hf * KOS + 2 * c; LAS unsigned char* ip = lds + L_KI + 32 * hf * KOS + 2 * c;
#pragma unroll
            for (int i = 0; i < 32; ++i) { const float b = val[i];
                const float q = bf1(*(const LAS unsigned short*)(qp + i * KOS)), k = bf1(*(const LAS unsigned short*)(kp + i * KOS));
                *(LAS unsigned short*)(qp + i * KOS) = f2bf1(q * 0.14433756729740643f * __expf(b)); *(LAS unsigned short*)(ip + i * KOS) = f2bf1(k * __expf(-b));
                *(LAS unsigned short*)(kp + i * KOS) = f2bf1(k * __expf(bl - b)); } }
        __syncthreads();
#pragma unroll
        for (int i = 0; i < 3; ++i) { const int idx = tid + 512 * i, row = idx / 24, c8 = idx % 24;
            *(u32x4*)(a.QD + (t0 + row) * 192 + 8 * c8) = *(const LAS u32x4*)(lds + L_Q + row * KOS + 16 * c8);
            *(u32x4*)(a.KI + (t0 + row) * 192 + 8 * c8) = *(const LAS u32x4*)(lds + L_KI + row * KOS + 16 * c8); }
        __syncthreads();
#pragma unroll
        for (int i = 0; i < 6; ++i) { const int idx = tid + 512 * i, row = idx / 48, c8 = idx % 48; *(LAS u32x4*)(lds + L_V + row * VSG + 16 * c8) = vreg[i]; }
        __syncthreads();
        bf16x8 wpl[2][4]; f32x4 psc[4];
        if constexpr (POOL) { const int gi = wave >> 1, g4 = lane >> 4, lr = lane & 15;
#pragma unroll
          for (int ks = 0; ks < 2; ++ks)
#pragma unroll
              for (int m = 0; m < 4; ++m) wpl[ks][m] = *(const bf16x8*)(a.WPLT + ((size_t)gi * 64 + 16 * m + lr) * 64 + 32 * ks + 8 * g4);
#pragma unroll
          for (int m = 0; m < 4; ++m) psc[m] = *(const f32x4*)(a.pool_scale + gi * 64 + 16 * m + 4 * g4); }
        { const int h = wave >> 1, half = wave & 1, g4 = lane >> 4, q = (lane & 15) >> 2, p = lane & 3;
          f32x4 acc[3][3];
#pragma unroll
          for (int m = 0; m < 3; ++m)
#pragma unroll
              for (int n = 0; n < 3; ++n) acc[m][n] = (f32x4){0.f, 0.f, 0.f, 0.f};
#pragma unroll
          for (int ks = 0; ks < 2; ++ks) {
              const int tokr = 32 * ks + 8 * g4 + q;
              bf16x8 bf[3];
#pragma unroll
              for (int n = 0; n < 3; ++n) { s16x4 lo, hi; const unsigned ad = (unsigned)(L_KO + tokr * KOS + (h * 48 + 16 * n + 4 * p) * 2); tr_read2(lo, hi, ad, ad + 4 * KOS);
                  bf[n] = __builtin_shufflevector(lo, hi, 0, 1, 2, 3, 4, 5, 6, 7); }
#pragma unroll
              for (int m = 0; m < 3; ++m) { s16x4 lo, hi; const unsigned ad = (unsigned)(L_V + tokr * VSG + (h * 96 + 16 * (3 * half + m) + 4 * p) * 2); tr_read2(lo, hi, ad, ad + 4 * VSG);
                  const bf16x8 af = __builtin_shufflevector(lo, hi, 0, 1, 2, 3, 4, 5, 6, 7);
#pragma unroll
                  for (int n = 0; n < 3; ++n) acc[m][n] = __builtin_amdgcn_mfma_f32_16x16x32_bf16(af, bf[n], acc[m][n], 0, 0, 0); }
          }
          float* kv = a.KVT + ((size_t)ch * 4 + h) * 96 * 48;
#pragma unroll
          for (int m = 0; m < 3; ++m)
#pragma unroll
              for (int n = 0; n < 3; ++n)
#pragma unroll
                  for (int jj = 0; jj < 4; ++jj) kv[(16 * (3 * half + m) + 4 * g4 + jj) * 48 + 16 * n + (lane & 15)] = acc[m][n][jj];
        }
        if constexpr (POOL) { const int gi = wave >> 1, half = wave & 1, g4 = lane >> 4, lr = lane & 15;
          f32x4 acc[4][2];
#pragma unroll
          for (int m = 0; m < 4; ++m) { acc[m][0] = (f32x4){0.f, 0.f, 0.f, 0.f}; acc[m][1] = (f32x4){0.f, 0.f, 0.f, 0.f}; }
#pragma unroll
          for (int ks = 0; ks < 2; ++ks) {
              bf16x8 bf[2];
#pragma unroll
              for (int n = 0; n < 2; ++n) bf[n] = *(const LAS bf16x8*)(lds + L_PL + (16 * (2 * half + n) + lr) * PLS + (gi * 64 + 32 * ks + 8 * g4) * 2);
#pragma unroll
              for (int m = 0; m < 4; ++m) { const bf16x8 af = wpl[ks][m];
                  acc[m][0] = __builtin_amdgcn_mfma_f32_16x16x32_bf16(af, bf[0], acc[m][0], 0, 0, 0); acc[m][1] = __builtin_amdgcn_mfma_f32_16x16x32_bf16(af, bf[1], acc[m][1], 0, 0, 0); }
          }
#pragma unroll
          for (int m = 0; m < 4; ++m) { const int d0 = gi * 64 + 16 * m + 4 * g4; const f32x4 sc = psc[m];
#pragma unroll
              for (int n = 0; n < 2; ++n) { const size_t row = t0 + 16 * (2 * half + n) + lr; u32x2 o; o.x = cvtpk(acc[m][n][0] * sc.x, acc[m][n][1] * sc.y); o.y = cvtpk(acc[m][n][2] * sc.z, acc[m][n][3] * sc.w);
                  *(u32x2*)(a.MIX + row * 1024 + 768 + d0) = o; } }
        }
    }
}

constexpr int UST = 144;
__device__ __forceinline__ void pool_wave(LAS unsigned char* ubuf, LAS unsigned char* pbuf, const unsigned short* PROJ, const unsigned short* WPLT, const float* pool_scale, unsigned short* MIX, const int ch, const int gi, const int lane) {
    const size_t t0 = (size_t)ch * 64; const int tpos0 = (ch & 63) * 64; const int g4 = lane >> 4, lr = lane & 15;
    bf16x8 wpl[2][4]; f32x4 psc[4];
#pragma unroll
    for (int ks = 0; ks < 2; ++ks)
#pragma unroll
        for (int m = 0; m < 4; ++m) wpl[ks][m] = *(const bf16x8*)(WPLT + ((size_t)gi * 64 + 16 * m + lr) * 64 + 32 * ks + 8 * g4);
#pragma unroll
    for (int m = 0; m < 4; ++m) psc[m] = *(const f32x4*)(pool_scale + gi * 64 + 16 * m + 4 * g4);
    u32x4 uv[10];
#pragma unroll
    for (int i = 0; i < 10; ++i) { const int idx = lane + 64 * i, row = idx >> 3, c8 = idx & 7; uv[i] = (u32x4){0u, 0u, 0u, 0u};
        if (tpos0 - 16 + row >= 0) uv[i] = *(const u32x4*)(PROJ + (t0 + row - 16) * LDP + C_PU + gi * 64 + 8 * c8); }
#pragma unroll
    for (int i = 0; i < 10; ++i) { const int idx = lane + 64 * i, row = idx >> 3, c8 = idx & 7; *(LAS u32x4*)(ubuf + row * UST + 16 * c8) = uv[i]; }
    { const int w = 2 << gi; const LAS unsigned char* up = ubuf + 2 * lane + 16 * UST; LAS unsigned char* pp = pbuf + 2 * lane;
      float ws = 0.f;
      for (int i = 1; i <= w; ++i) ws += bf1(*(const LAS unsigned short*)(up - i * UST));
#pragma unroll 8
      for (int i = 0; i < 64; ++i) { const float u = bf1(*(const LAS unsigned short*)(up + i * UST));
          ws += u - bf1(*(const LAS unsigned short*)(up + (i - w) * UST));
          const int tp = tpos0 + i; const int cnt = (tp + 1 < w) ? tp + 1 : w;
          *(LAS unsigned short*)(pp + i * UST) = f2bf1(ws * __builtin_amdgcn_rcpf((float)cnt) - u); } }
#pragma unroll
    for (int half = 0; half < 2; ++half) {
        f32x4 acc[4][2];
#pragma unroll
        for (int m = 0; m < 4; ++m) { acc[m][0] = (f32x4){0.f, 0.f, 0.f, 0.f}; acc[m][1] = (f32x4){0.f, 0.f, 0.f, 0.f}; }
#pragma unroll
        for (int ks = 0; ks < 2; ++ks) { bf16x8 bf[2];
#pragma unroll
            for (int n = 0; n < 2; ++n) bf[n] = *(const LAS bf16x8*)(pbuf + (16 * (2 * half + n) + lr) * UST + (32 * ks + 8 * g4) * 2);
#pragma unroll
            for (int m = 0; m < 4; ++m) { acc[m][0] = __builtin_amdgcn_mfma_f32_16x16x32_bf16(wpl[ks][m], bf[0], acc[m][0], 0, 0, 0); acc[m][1] = __builtin_amdgcn_mfma_f32_16x16x32_bf16(wpl[ks][m], bf[1], acc[m][1], 0, 0, 0); } }
#pragma unroll
        for (int m = 0; m < 4; ++m) { const int d0 = gi * 64 + 16 * m + 4 * g4; const f32x4 sc = psc[m];
#pragma unroll
            for (int n = 0; n < 2; ++n) { const size_t row = t0 + 16 * (2 * half + n) + lr; u32x2 o; o.x = cvtpk(acc[m][n][0] * sc.x, acc[m][n][1] * sc.y); o.y = cvtpk(acc[m][n][2] * sc.z, acc[m][n][3] * sc.w);
                *(u32x2*)(MIX + row * 1024 + 768 + d0) = o; } }
    }
}

__device__ __forceinline__ void gla2_phase(const float* KVT, const float* DEC, unsigned short* STB, const int gtid, const int GT) {
    for (int e = gtid; e < 4 * 4 * 96 * 48; e += GT) {
        const int d = e % 48; int r = e / 48; const int v = r % 96; r /= 96; const int h = r & 3, b = r >> 2;
        float st = 0.f;
#pragma unroll 16
        for (int n = 0; n < 64; ++n) { const size_t chn = (size_t)b * 64 + n; const size_t idx = ((chn * 4 + h) * 96 + v) * 48 + d;
            STB[idx] = f2bf1(st); st = DEC[chn * 192 + h * 48 + d] * st + KVT[idx]; }
    }
}

struct G3Args { const unsigned short* PROJ; const unsigned short* QD; const unsigned short* KI; const unsigned short* STB; const float* norm_g; unsigned short* MIX; };
__device__ __forceinline__ void gla3_phase(LAS unsigned char* lds, const G3Args& a, const int vcu, const int G, const int wave, const int lane, const int tid) {
    const int r = lane & 31, hh = lane >> 5, h = wave >> 1, c0 = 32 * (wave & 1);
    const unsigned tra = (unsigned)(L_V + ((lane & 15) >> 2) * VSG + (((lane >> 4) & 1) * 16 + (lane & 3) * 4) * 2);
    for (int ch = vcu; ch < 256; ch += G) {
        const size_t t0 = (size_t)ch * 64;
        __syncthreads();
        stage_v(lds, a.PROJ, t0, tid);
        bf16x8 qd[3];
#pragma unroll
        for (int ks = 0; ks < 3; ++ks) qd[ks] = *(const bf16x8*)(a.QD + (t0 + c0 + r) * 192 + h * 48 + 16 * ks + 8 * hh);
        bf16x8 sf[3][3]; u32x2 gog[3][4];
#pragma unroll
        for (int vb = 0; vb < 3; ++vb)
#pragma unroll
            for (int ks = 0; ks < 3; ++ks) sf[vb][ks] = *(const bf16x8*)(a.STB + (((size_t)ch * 4 + h) * 96 + 32 * vb + r) * 48 + 16 * ks + 8 * hh);
#pragma unroll
        for (int vb = 0; vb < 3; ++vb)
#pragma unroll
            for (int u = 0; u < 4; ++u) gog[vb][u] = *(const u32x2*)(a.PROJ + (t0 + c0 + r) * LDP + C_GO + h * 96 + 32 * vb + 8 * u + 4 * hh);
        float att[2][16];
#pragma unroll
        for (int sb = 0; sb < 2; ++sb) { f32x16 t;
#pragma unroll
            for (int i = 0; i < 16; ++i) t[i] = 0.f;
#pragma unroll
            for (int ks = 0; ks < 3; ++ks) { const bf16x8 kf = *(const bf16x8*)(a.KI + (t0 + 32 * sb + r) * 192 + h * 48 + 16 * ks + 8 * hh); t = __builtin_amdgcn_mfma_f32_32x32x16_bf16(kf, qd[ks], t, 0, 0, 0); }
#pragma unroll
            for (int i = 0; i < 16; ++i) { const int s = 32 * sb + (i & 3) + 8 * (i >> 2) + 4 * hh; att[sb][i] = (s <= c0 + r) ? t[i] : 0.f; } }
        __syncthreads();
        f32x16 o[3];
#pragma unroll
        for (int vb = 0; vb < 3; ++vb)
#pragma unroll
            for (int i = 0; i < 16; ++i) o[vb][i] = 0.f;
#pragma unroll
        for (int sb = 0; sb < 2; ++sb)
#pragma unroll
            for (int s2 = 0; s2 < 2; ++s2) { const bf16x8 pb = pack_step(att[sb], s2);
                const unsigned a_lo = tra + (unsigned)((32 * sb + 16 * s2 + 4 * hh) * VSG + h * 96 * 2);
#pragma unroll
                for (int vb = 0; vb < 3; ++vb) { s16x4 lo, hi; tr_read2(lo, hi, a_lo + 64 * vb, a_lo + 64 * vb + 8 * VSG);
                    o[vb] = __builtin_amdgcn_mfma_f32_32x32x16_bf16(__builtin_shufflevector(lo, hi, 0, 1, 2, 3, 4, 5, 6, 7), pb, o[vb], 0, 0, 0); } }
#pragma unroll
        for (int vb = 0; vb < 3; ++vb)
#pragma unroll
            for (int ks = 0; ks < 3; ++ks) o[vb] = __builtin_amdgcn_mfma_f32_32x32x16_bf16(sf[vb][ks], qd[ks], o[vb], 0, 0, 0);
        float ss = 0.f;
#pragma unroll
        for (int vb = 0; vb < 3; ++vb)
#pragma unroll
            for (int i = 0; i < 16; ++i) ss += o[vb][i] * o[vb][i];
        ss += partner32(ss, hh);
        const float rs = 1.0f / sqrtf(ss * (1.0f / 96.0f) + 1e-6f);
        const size_t row = t0 + c0 + r;
#pragma unroll
        for (int vb = 0; vb < 3; ++vb)
#pragma unroll
            for (int u = 0; u < 4; ++u) { const int v0 = 32 * vb + 8 * u + 4 * hh; const u32x2 go = gog[vb][u]; const f32x4 ng = *(const f32x4*)(a.norm_g + v0);
                const float g0 = bflo(go.x), g1 = bfhi(go.x), g2 = bflo(go.y), g3 = bfhi(go.y);
                const float y0 = o[vb][4 * u] * rs * ng.x * g0 * __builtin_amdgcn_rcpf(1.0f + __expf(-g0)), y1 = o[vb][4 * u + 1] * rs * ng.y * g1 * __builtin_amdgcn_rcpf(1.0f + __expf(-g1));
                const float y2 = o[vb][4 * u + 2] * rs * ng.z * g2 * __builtin_amdgcn_rcpf(1.0f + __expf(-g2)), y3 = o[vb][4 * u + 3] * rs * ng.w * g3 * __builtin_amdgcn_rcpf(1.0f + __expf(-g3));
                u32x2 w; w.x = cvtpk(y0, y1); w.y = cvtpk(y2, y3); *(u32x2*)(a.MIX + row * 1024 + h * 96 + v0) = w; }
    }
}
}

#define XB_TMO      128
#define XB_XCNT(j)  (256  + 64 * (j))
#define XB_XSUB(j)  (1280 + 64 * (j))
#define XB_XGEN(j)  (2304 + 64 * (j))
#define XB_TOP      3328
#define XB_TOPGEN   3392
#define XCD_BAR_WORDS 3456
#define XB_SPIN_CAP (1u << 22)
__device__ __forceinline__ unsigned xb_ld(unsigned* p)              { return __hip_atomic_load(p, __ATOMIC_RELAXED, __HIP_MEMORY_SCOPE_AGENT); }
__device__ __forceinline__ unsigned xb_add(unsigned* p, unsigned v) { return __hip_atomic_fetch_add(p, v, __ATOMIC_RELAXED, __HIP_MEMORY_SCOPE_AGENT); }
__device__ __forceinline__ unsigned xb_xcc_id() { return (unsigned)__builtin_amdgcn_s_getreg((3 << 11) | 20) & 0xFu; }
#define XB_SPIN(cond, bar) do { unsigned _sp = 0; while (cond) { __builtin_amdgcn_s_sleep(1); \
    if ((++_sp & 255u) == 0u) { if (xb_ld(&(bar)[XB_TMO])) break; if (_sp > XB_SPIN_CAP) { atomicAdd(&(bar)[XB_TMO], 1u); break; } } } } while (0)
struct XcdBarrier { unsigned* bar; unsigned x; volatile LAS unsigned* st; };
__device__ __forceinline__ XcdBarrier xcd_barrier_post(unsigned* bar, volatile LAS unsigned* st) {
    XcdBarrier b; b.bar = bar; b.x = xb_xcc_id(); b.st = st;
    if (threadIdx.x == 0) (void)xb_add(&bar[XB_XCNT(b.x)], 1u);
    return b;
}
__device__ __forceinline__ void xcd_barrier_complete(unsigned* bar, unsigned x, unsigned& nloc, unsigned& nx) {
    const unsigned G = gridDim.x * gridDim.y * gridDim.z;
    unsigned sum, cnt, mine, sp = 0u;
    for (;;) {
        sum = 0u; cnt = 0u; mine = 0u;
#pragma unroll
        for (unsigned j = 0; j < 16; ++j) { const unsigned c = xb_ld(&bar[XB_XCNT(j)]); sum += c; cnt += (c > 0u) ? 1u : 0u; mine = (j == x) ? c : mine; }
        if (sum == G) break;
        __builtin_amdgcn_s_sleep(1);
        if ((++sp & 255u) == 0u) { if (xb_ld(&bar[XB_TMO])) break; if (sp > XB_SPIN_CAP) { atomicAdd(&bar[XB_TMO], 1u); break; } }
    }
    nloc = mine > 0u ? mine : 1u; nx = cnt > 0u ? cnt : 1u;
}
__device__ __forceinline__ void xcd_barrier(const XcdBarrier& b) {
    asm volatile("s_waitcnt vmcnt(0)" ::: "memory");
    __syncthreads();
    if (threadIdx.x == 0) {
        unsigned* bar = b.bar;
        __builtin_amdgcn_s_waitcnt(0);
        unsigned nloc = b.st[0], nx = b.st[1];
        if (nloc == 0u) { xcd_barrier_complete(bar, b.x, nloc, nx); b.st[0] = nloc; b.st[1] = nx; }
        const unsigned old = xb_add(&bar[XB_XSUB(b.x)], 1u);
        const unsigned gen = old / nloc;
        if (old + 1u == (gen + 1u) * nloc) {
            __builtin_amdgcn_fence(__ATOMIC_RELEASE, "agent");
            asm volatile("s_waitcnt vmcnt(0)" ::: "memory");
            const unsigned og = xb_add(&bar[XB_TOP], 1u);
            const unsigned tg = og / nx;
            if (og + 1u == (tg + 1u) * nx) xb_add(&bar[XB_TOPGEN], 1u);
            else XB_SPIN(xb_ld(&bar[XB_TOPGEN]) == tg, bar);
            __builtin_amdgcn_fence(__ATOMIC_ACQUIRE, "agent");
            xb_add(&bar[XB_XGEN(b.x)], 1u);
            asm volatile("s_waitcnt vmcnt(0)" ::: "memory");
        } else {
            XB_SPIN(xb_ld(&bar[XB_XGEN(b.x)]) == gen, bar);
            __builtin_amdgcn_fence(__ATOMIC_ACQUIRE, "agent");
            asm volatile("s_waitcnt vmcnt(0)" ::: "memory");
        }
    }
    __syncthreads();
}

constexpr int NTHREADS = 512, NWAVES = 8;
constexpr int LDS_MISC = 151552 - 1024;
constexpr int LDS_BYTES = 151552;
constexpr int T_ = 16384, D_ = 1024, LDP_ = 2816, NSLOT = 41216  ;
typedef unsigned short bf16;
typedef float f32x4 __attribute__((ext_vector_type(4)));
typedef float f32x2 __attribute__((ext_vector_type(2)));
typedef unsigned v4u __attribute__((ext_vector_type(4)));
typedef unsigned v2u __attribute__((ext_vector_type(2)));
constexpr size_t al256(size_t x) { return (x + 255) & ~(size_t)255; }
constexpr size_t OFF_CTL = 0, CTL_BYTES = 65536;
constexpr int CW_CNT = 4096, CW_FILL = 4096 + 1024, CW_RDY = 8192;
constexpr int CW_FIN = 14880;
constexpr int CW_TMO = 16000;
constexpr size_t OFF_WIN = CTL_BYTES;
constexpr size_t OFF_WOUT = OFF_WIN + (size_t)LDP_ * D_ * 2;
constexpr size_t OFF_WGU = OFF_WOUT + (size_t)D_ * D_ * 2;
constexpr size_t OFF_WD = OFF_WGU + (size_t)32 * 512 * D_ * 2;
constexpr size_t OFF_WPG = OFF_WD + (size_t)32 * D_ * 256 * 2;
constexpr size_t OFF_WPP = OFF_WPG + (size_t)D_ * D_ * 2;
constexpr size_t OFF_WR = OFF_WPP + (size_t)D_ * 256 * 2;
constexpr size_t OFF_HB = OFF_WR + (size_t)128 * 1024 * 2;
constexpr size_t OFF_PB = OFF_HB + (size_t)2 * T_ * D_ * 2;
constexpr size_t OFF_PROJ = OFF_PB + (size_t)T_ * 256 * 2;
constexpr size_t OFF_HID = OFF_PROJ;
constexpr size_t OFF_Y = OFF_HID + (size_t)NSLOT * 256 * 2;
constexpr size_t OFF_MIX = OFF_PROJ + (size_t)T_ * LDP_ * 2;
constexpr size_t OFF_EB = OFF_MIX + (size_t)T_ * D_ * 2;
constexpr size_t OFF_RSTD = OFF_EB + (size_t)T_ * D_ * 2;
constexpr size_t OFF_SS = OFF_RSTD + (size_t)3 * T_ * 4;
constexpr size_t OFF_QD = OFF_SS + (size_t)T_ * 16 * 4;
constexpr size_t OFF_KI = OFF_QD + (size_t)T_ * 192 * 2;
constexpr size_t OFF_KVT = OFF_KI + (size_t)T_ * 192 * 2;
constexpr size_t OFF_DEC = OFF_KVT + (size_t)256 * 4 * 96 * 48 * 4;
constexpr size_t OFF_STB = OFF_DEC + (size_t)256 * 192 * 4;
constexpr size_t OFF_WPL = OFF_STB + (size_t)256 * 4 * 96 * 48 * 2;
constexpr size_t OB_PB = 0, OB_WPP = (size_t)T_ * 1024 * 2;
constexpr size_t WS_END = OFF_WPL + (size_t)4 * 64 * 64 * 2;
constexpr int VCAP = T_;
constexpr size_t OFF_VTOK = OFF_KVT, OFF_VW = OFF_VTOK + (size_t)32 * VCAP * 4;
static_assert(OFF_VW + (size_t)32 * VCAP * 4 <= OFF_DEC, "virtual slot lists fit in the KVT region");
static_assert(OFF_Y + ((size_t)2 * T_ + 1) * D_ * 2 <= OFF_MIX, "HID | Y (+ one trash row) fit in the PROJ region");

__device__ __forceinline__ unsigned f2bf(float f) { unsigned u = __float_as_uint(f); return (u + 0x7fffu + ((u >> 16) & 1u)) >> 16; }
__device__ __forceinline__ unsigned pk2(float lo, float hi) { return f2bf(lo) | (f2bf(hi) << 16); }
__device__ __forceinline__ float bflo(unsigned u) { return __uint_as_float(u << 16); }
__device__ __forceinline__ float bfhi(unsigned u) { return __uint_as_float(u & 0xffff0000u); }
template <class T> __device__ __forceinline__ T* launder(T* p) { asm volatile("" : "+s"(p)); return p; }
__device__ __forceinline__ int hw_lane() { unsigned m = ~0u; asm volatile("" : "+s"(m)); return (int)__builtin_amdgcn_mbcnt_hi(m, __builtin_amdgcn_mbcnt_lo(m, 0u)); }
template <int XOR> __device__ __forceinline__ float swz_xor(float v) { return __int_as_float(__builtin_amdgcn_ds_swizzle(__float_as_int(v), (XOR << 10) | 0x1f)); }
__device__ __forceinline__ float xor32_sum(float v) { const auto r = __builtin_amdgcn_permlane32_swap(__float_as_uint(v), __float_as_uint(v), false, false); return __uint_as_float(r[0]) + __uint_as_float(r[1]); }
__device__ __forceinline__ float wave_sum(float v) {
    v += swz_xor<1>(v); v += swz_xor<2>(v); v += swz_xor<4>(v); v += swz_xor<8>(v); v += swz_xor<16>(v);
    return xor32_sum(v);
}
__device__ __forceinline__ float fsigmoid(float x) { return __builtin_amdgcn_rcpf(1.0f + __expf(-x)); }

struct TItem { const float* W; const float* g; bf16* WT; int N, ldt, dst_row0, kb, nb; };
__device__ __forceinline__ void titem_load(const TItem& t, f32x4 (&v)[8], float (&gg)[8], int lane) {
    const int k0 = 64 * t.kb, n0 = 32 * t.nb; const int c4 = lane & 7, kr = lane >> 3; const int n = n0 + 4 * c4;
#pragma unroll
    for (int i = 0; i < 8; ++i) { const int kk = 8 * i + kr; v[i] = (n < t.N) ? *(const f32x4*)(t.W + (size_t)(k0 + kk) * t.N + n) : (f32x4){0.f, 0.f, 0.f, 0.f}; gg[i] = t.g ? t.g[k0 + kk] : 1.0f; }
}
__device__ __forceinline__ void titem_finish(const TItem& t, const f32x4 (&v)[8], const float (&gg)[8], LAS float* scr, int lane) {
    const int k0 = 64 * t.kb; const int c4 = lane & 7, kr = lane >> 3;
#pragma unroll
    for (int i = 0; i < 8; ++i) { const int kk = 8 * i + kr; LAS float* d = scr + kk * 33 + 4 * c4; d[0] = v[i].x * gg[i]; d[1] = v[i].y * gg[i]; d[2] = v[i].z * gg[i]; d[3] = v[i].w * gg[i]; }
    asm volatile("s_waitcnt lgkmcnt(0)" ::: "memory");
    const int c = lane & 7;
#pragma unroll
    for (int j = 0; j < 4; ++j) { const int nn = (lane >> 3) + 8 * j; const LAS float* s = scr + (8 * c) * 33 + nn;
        v4u o; o.x = pk2(s[0 * 33], s[1 * 33]); o.y = pk2(s[2 * 33], s[3 * 33]); o.z = pk2(s[4 * 33], s[5 * 33]); o.w = pk2(s[6 * 33], s[7 * 33]);
        *(v4u*)(t.WT + (size_t)(t.dst_row0 + nn) * t.ldt + k0 + 8 * c) = o; }
    asm volatile("s_waitcnt lgkmcnt(0)" ::: "memory");
}
__device__ __forceinline__ void transpose_item(const float* W, const float* g, int K, int N, bf16* WT, int dst_row0, LAS float* scr, int kb, int nb, int lane, int ldt = 0) {
    if (ldt == 0) ldt = K;
    const int k0 = 64 * kb, n0 = 32 * nb; const int c4 = lane & 7, kr = lane >> 3; const int n = n0 + 4 * c4;
    f32x4 v[8]; float gg[8];
#pragma unroll
    for (int i = 0; i < 8; ++i) { const int kk = 8 * i + kr; v[i] = (n < N) ? *(const f32x4*)(W + (size_t)(k0 + kk) * N + n) : (f32x4){0.f, 0.f, 0.f, 0.f}; gg[i] = g ? g[k0 + kk] : 1.0f; }
#pragma unroll
    for (int i = 0; i < 8; ++i) { const int kk = 8 * i + kr; LAS float* d = scr + kk * 33 + 4 * c4; d[0] = v[i].x * gg[i]; d[1] = v[i].y * gg[i]; d[2] = v[i].z * gg[i]; d[3] = v[i].w * gg[i]; }
    asm volatile("s_waitcnt lgkmcnt(0)" ::: "memory");
    const int c = lane & 7;
#pragma unroll
    for (int j = 0; j < 4; ++j) { const int nn = (lane >> 3) + 8 * j; const LAS float* s = scr + (8 * c) * 33 + nn;
        v4u o; o.x = pk2(s[0 * 33], s[1 * 33]); o.y = pk2(s[2 * 33], s[3 * 33]); o.z = pk2(s[4 * 33], s[5 * 33]); o.w = pk2(s[6 * 33], s[7 * 33]);
        *(v4u*)(WT + (size_t)(dst_row0 + nn) * ldt + k0 + 8 * c) = o; }
    asm volatile("s_waitcnt lgkmcnt(0)" ::: "memory");
}
__device__ __forceinline__ void row_to_bf16_rstd(const float* xrow, bf16* orow, float* rstd, int lane) {
    const f32x4* xr = (const f32x4*)xrow + lane;
    f32x4 v[4]; float s = 0.f;
#pragma unroll
    for (int j = 0; j < 4; ++j) { v[j] = xr[64 * j]; s += (v[j].x * v[j].x + v[j].y * v[j].y) + (v[j].z * v[j].z + v[j].w * v[j].w); }
    s = wave_sum(s);
    if (lane == 0) *rstd = 1.0f / sqrtf(s * (1.0f / 1024.0f) + 1e-6f);
    unsigned long long* o8 = (unsigned long long*)orow + lane;
#pragma unroll
    for (int j = 0; j < 4; ++j) o8[64 * j] = (unsigned long long)pk2(v[j].x, v[j].y) | ((unsigned long long)pk2(v[j].z, v[j].w) << 32);
}

struct LayerIn { const float *x, *pl, *norm1_g, *w_in, *w_out, *norm2_g, *rg_w, *re_w, *wg, *wu, *wd, *ple_g, *ple_w, *ple_p, *pool_w; };
template <int MODE> __device__ __forceinline__ void prologue_phase(LAS unsigned char* lds, const LayerIn& I, unsigned char* ws, unsigned char* obuf, int l, int gw, int NGW, int wave, int lane, int gtid, int GT) {
    LAS float* scr = (LAS float*)(lds + wave * 16384);
    if (MODE == 0 && l == 0) { float* RSTD1 = (float*)(ws + OFF_RSTD); bf16* Hb = (bf16*)(ws + OFF_HB);
        for (int m0 = gw; m0 < T_; m0 += 4 * NGW) {
            f32x4 v[4][4]; float ss[4];
#pragma unroll
            for (int q = 0; q < 4; ++q) { const int m = m0 + q * NGW; const f32x4* xr = (const f32x4*)(I.x + (size_t)(m < T_ ? m : m0) * 1024) + lane;
#pragma unroll
                for (int j = 0; j < 4; ++j) v[q][j] = xr[64 * j]; }
#pragma unroll
            for (int q = 0; q < 4; ++q) { float s = 0.f;
#pragma unroll
                for (int j = 0; j < 4; ++j) s += (v[q][j].x * v[q][j].x + v[q][j].y * v[q][j].y) + (v[q][j].z * v[q][j].z + v[q][j].w * v[q][j].w);
                ss[q] = s; }
#pragma unroll
            for (int q = 0; q < 4; ++q) ss[q] = wave_sum(ss[q]);
#pragma unroll
            for (int q = 0; q < 4; ++q) { const int m = m0 + q * NGW; if (m < T_) { if (lane == 0) RSTD1[m] = 1.0f / sqrtf(ss[q] * (1.0f / 1024.0f) + 1e-6f);
                unsigned long long* o8 = (unsigned long long*)(Hb + (size_t)m * 1024) + lane;
#pragma unroll
                for (int j = 0; j < 4; ++j) o8[64 * j] = (unsigned long long)pk2(v[q][j].x, v[q][j].y) | ((unsigned long long)pk2(v[q][j].z, v[q][j].w) << 32); } } } }
    if constexpr (MODE != 2) {
    bf16* WinT = (bf16*)(ws + OFF_WIN); bf16* WoutT = (bf16*)(ws + OFF_WOUT); bf16* WguT = (bf16*)(ws + OFF_WGU); bf16* WdT = (bf16*)(ws + OFF_WD); bf16* WpgT = (bf16*)(ws + ((l & 1) ? OFF_PB : OFF_WPG));        bf16* WppT = (bf16*)(obuf + OB_WPP);
    constexpr int I_IN = 16 * 88, I_OUT = 16 * 32, I_GU = 32 * 2 * 16 * 8, I_D = 32 * 4 * 32, I_PG = 16 * 32, I_PP = 4 * 32;
    constexpr int NITEMS = I_IN + I_OUT + I_GU + I_D + I_PG + I_PP;
    auto decode = [&](int it) -> TItem {
        int r = it;
        if (r < I_IN) return TItem{I.w_in, I.norm1_g, WinT, 2576, 1024, (r % 88) * 32, r / 88, r % 88}; r -= I_IN;
        if (r < I_OUT) return TItem{I.w_out, nullptr, WoutT, 1024, 1024, (r % 32) * 32, r / 32, r % 32}; r -= I_OUT;
        if (r < I_GU) { const int e = r / 256, q = r % 256, up = q / 128, kb = (q % 128) / 8, nb = q % 8;
            return TItem{(up ? I.wu : I.wg) + (size_t)e * 1024 * 256, I.norm2_g, WguT + (size_t)e * 512 * 1024, 256, 1024, (nb / 4) * 256 + up * 128 + (nb % 4) * 32, kb, nb}; } r -= I_GU;
        if (r < I_D) { const int e = r / 128, q = r % 128; return TItem{I.wd + (size_t)e * 256 * 1024, nullptr, WdT + (size_t)e * 1024 * 256, 1024, 256, (q % 32) * 32, q / 32, q % 32}; } r -= I_D;
        if (r < I_PG) return TItem{I.ple_w, I.ple_g, WpgT, 1024, 1024, (r % 32) * 32, r / 32, r % 32}; r -= I_PG;
        return TItem{I.ple_p, nullptr, WppT, 1024, 1024, (r % 32) * 32, r / 32, r % 32};
    };
    if (gw < NITEMS) {
        TItem cur = decode(gw); f32x4 v[8]; float gg[8];
        titem_load(cur, v, gg, lane);
        for (int it = gw; it < NITEMS; it += NGW) {
            const bool more = it + NGW < NITEMS;
            TItem nxt = cur; f32x4 vn[8]; float gn[8];
            if (more) { nxt = decode(it + NGW); titem_load(nxt, vn, gn, lane); }
            titem_finish(cur, v, gg, scr, lane);
            if (more) { cur = nxt;
#pragma unroll
                for (int i = 0; i < 8; ++i) { v[i] = vn[i]; gg[i] = gn[i]; } }
        }
    }
    { bf16* WR = (bf16*)(ws + OFF_WR);
      for (int i = gtid; i < 128 * 1024; i += GT) { const int k = i & 1023, n = i >> 10; const int blk = n >> 5, rr = n & 31; const int j = (blk < 2) ? rr : 32 + rr; const bool lo = blk & 1;
          unsigned o = 0u;
          if (blk < 2 || rr < 4) { const float w = I.norm2_g[k] * (j < 4 ? I.rg_w[k * 4 + j] : I.re_w[k * 32 + (j - 4)]); const unsigned hi = f2bf(w); o = lo ? f2bf(w - bflo(hi)) : hi; }
          WR[i] = (bf16)o; } }
    { bf16* WPL = (bf16*)(ws + OFF_WPL); for (int i = gtid; i < 4 * 64 * 64; i += GT) { const int c = i & 63, d = (i >> 6) & 63, g = i >> 12; WPL[i] = (bf16)f2bf(I.pool_w[(g * 64 + c) * 64 + d]); } }
    bf16* Pb = (bf16*)(obuf + OB_PB);
    { f32x4 v[8];
#pragma unroll
      for (int u = 0; u < 8; ++u) v[u] = ((const f32x4*)I.pl)[gtid + u * GT];
#pragma unroll
      for (int u = 0; u < 8; ++u) { const int i4 = gtid + u * GT, row = i4 >> 6, c4 = i4 & 63; v2u o; o.x = pk2(v[u].x, v[u].y); o.y = pk2(v[u].z, v[u].w); *(v2u*)(Pb + (size_t)row * 1024 + 4 * c4) = o; } }
    }
    if constexpr (MODE == 2)
    if (l != 0) { float* RSTD1 = (float*)(ws + OFF_RSTD);
      { const float* SS = (const float*)(ws + OFF_SS);
        for (int m = gtid; m < T_; m += GT) { const f32x4* s4 = (const f32x4*)(SS + (size_t)m * 16); const f32x4 a = s4[0], b = s4[1], c = s4[2], d = s4[3];
            const float s = ((a.x + a.y) + (a.z + a.w)) + ((b.x + b.y) + (b.z + b.w)) + ((c.x + c.y) + (c.z + c.w)) + ((d.x + d.y) + (d.z + d.w));
            RSTD1[m] = 1.0f / sqrtf(s * (1.0f / 1024.0f) + 1e-6f); } } }
}

struct PlainSched {
    static constexpr bool GATHER = false, HOOKS = false, SKIPHI = false;
    int nM, nN, nwg, G, c, nt; const char* A; const char* Bt; size_t astep, bstep;
    __device__ __forceinline__ void init(const void* A_, const void* Bt_, int M, int N, int K, int lda, int ldb, int G_, int c_) {
        nM = M / 256; nN = N / 256; nwg = nM * nN; G = G_; c = c_; nt = K / 64; A = (const char*)A_; Bt = (const char*)Bt_; astep = (size_t)256 * lda * 2; bstep = (size_t)256 * ldb * 2; }
    __device__ __forceinline__ bool next(int i, gp::Unit& u) const {
        const long L = (long)i * G + c; if (L >= nwg) return false;
        int wgid = (int)L; { const int q = nwg / 8, r = nwg % 8, xcd = wgid % 8, off = wgid / 8; wgid = (xcd < r ? xcd * (q + 1) : r * (q + 1) + (xcd - r) * q) + off; }
        const int nig = 8 * nN, gid = wgid / nig, fm = gid * 8, gsz = (nM - fm) < 8 ? (nM - fm) : 8;
        u.pm = fm + ((wgid % nig) % gsz); u.pn = (wgid % nig) / gsz; u.aB = A + (size_t)u.pm * astep; u.bB = Bt + (size_t)u.pn * bstep; u.nt = nt; u.rl = nullptr; u.aux = 0; return true;
    }
};
struct ProjESched {
    static constexpr bool GATHER = false, HOOKS = false, SKIPHI = false;
    PlainSched P; const char* A2; const char* B2; int G, c, nfull, spare;
    __device__ __forceinline__ void init(const void* A, const void* Bt, const void* A2_, const void* B2_, int G_, int c_) {
        P.init(A, Bt, T_, LDP_, 1024, 1024, 1024, G_, c_); A2 = (const char*)A2_; B2 = (const char*)B2_; G = G_; c = c_;
        nfull = (P.nwg - c + G - 1) / G;
        const int rounds = (P.nwg + G - 1) / G; spare = (nfull < rounds) ? 1 : 0; }
    __device__ __forceinline__ bool next(int i, gp::Unit& u) const {
        if (i < nfull) return P.next(i, u);
        const int rounds = (P.nwg + G - 1) / G, first_spare = P.nwg - (rounds - 1) * G, nspare = G - first_spare;
        int e = -1; const int j = i - nfull;
        if (spare) { if (j < 4) e = (c - first_spare) * 4 + j; else if (4 * nspare < 256) { const long L = (long)(j - 4) * G + c + 4 * nspare; if (L < 256) e = (int)L; } }
        else if (4 * nspare < 256) { const long L = (long)j * G + c + 4 * nspare; if (L < 256) e = (int)L; }
        if (e < 0 || e >= 256) return false;
        u.pm = e >> 2; u.pn = e & 3; u.aB = A2 + (size_t)u.pm * 256 * 1024 * 2; u.bB = B2 + (size_t)u.pn * 256 * 1024 * 2; u.nt = 4; u.rl = nullptr; u.aux = 1; return true;
    }
};
__device__ __forceinline__ int toff_at(const volatile LAS int* toffs, int j) { unsigned o = 4u * (unsigned)j; asm volatile("" : "+v"(o)); return __builtin_amdgcn_readfirstlane(*(const volatile LAS int*)((const volatile LAS char*)toffs + o)); }
__device__ __forceinline__ int moe_ntile(const volatile LAS int* toffs) { const int w = toff_at(toffs, 32); return (w & 0xff) + ((w >> 8) & 0xff); }
__device__ __forceinline__ void moe_tile(const volatile LAS int* toffs, const int rt, int& e, int& tl, int& nv) {
    const int NN = toff_at(toffs, 32) & 0xff; int ee = 0;
    if (rt < NN) {
        for (int j = 1; j < 32; ++j) ee += (rt >= (toff_at(toffs, j) & 0xff)) ? 1 : 0;
        ee = __builtin_amdgcn_readfirstlane(ee);
        const int w = toff_at(toffs, ee), cnt = (w >> 8) & 0x7fff; tl = rt - (w & 0xff); nv = min(256, cnt - 256 * tl);
    } else {
        const int k = rt - NN;
        for (int j = 1; j < 32; ++j) ee += (k >= ((toff_at(toffs, j) >> 23) & 0x3f)) ? 1 : 0;
        ee = __builtin_amdgcn_readfirstlane(ee);
        const int cnt = (toff_at(toffs, ee) >> 8) & 0x7fff; tl = cnt >> 8; nv = cnt & 255;
    }
    e = ee;
}
struct MoeUpSched {
    static constexpr bool GATHER = true, HOOKS = true, SKIPHI = true;
    const volatile LAS int* toffs; int G, c; const char* A; const char* Bt; const int* lrow; unsigned* ready;
    __device__ __forceinline__ bool next(int i, gp::Unit& u) const {
        const int ntile = moe_ntile(toffs);
        const long L = (long)i * G + c; if (L >= (long)ntile * 2) return false;
        const int rt = (int)(L >> 1), pn = (int)(L & 1); int e, tl, nv;
        moe_tile(toffs, rt, e, tl, nv);
        u.pm = rt; u.pn = pn; u.aux = nv; u.rl = lrow + (size_t)e * VCAP + (size_t)tl * 256; u.aB = A; u.bB = Bt + ((size_t)e * 512 + (size_t)pn * 256) * 1024 * 2; u.nt = 16; return true;
    }
    __device__ __forceinline__ unsigned arow(const gp::Unit& u, int i) const { const int v = u.rl[i]; return i < u.aux ? (unsigned)(v >> 1) : 0u; }
    __device__ __forceinline__ void a_ready(const gp::Unit&) const {}
    __device__ __forceinline__ void done(const gp::Unit& u) const {
        asm volatile("s_waitcnt vmcnt(0)" ::: "memory");
        if (hw_lane() == 0) __hip_atomic_fetch_add(ready + 16 * u.pm, 1u, __ATOMIC_RELAXED, __HIP_MEMORY_SCOPE_AGENT);
    }
};
template <bool LATE> struct MoeDownSched {
    static constexpr bool GATHER = false, HOOKS = false, SKIPHI = true;
    const volatile LAS int* toffs; int G, c; const char* A; const char* Bt; const int* vtok;
    __device__ __forceinline__ int unit_of(int i) const {
        const int ntile = moe_ntile(toffs); const int nU = 2 * ntile, nD = 4 * ntile;
        const int nEarlyT = (nU <= G) ? ntile : G / 2, nEarly = 4 * nEarlyT;
        if (!LATE) { const int nb = (nU > G) ? nU - G : 0;
            if (nb >= G) { const long d = (long)c + (long)i * G; return d < nEarly ? (int)d : -1; }
            if (c < nb) return -1;
            const long d = (long)(c - nb) + (long)i * (G - nb); return d < nEarly ? (int)d : -1; }
        const long d = (long)nEarly + c + (long)i * G; return d < nD ? (int)d : -1;
    }
    __device__ __forceinline__ bool next(int i, gp::Unit& u) const {
        const int d = unit_of(i); if (d < 0) return false;
        const int rt = d >> 2, pn = d & 3; int e, tl, nv;
        moe_tile(toffs, rt, e, tl, nv);
        u.pm = rt; u.pn = pn; u.aux = nv; u.rl = vtok + (size_t)e * VCAP + (size_t)tl * 256; u.aB = A + (size_t)rt * 256 * 256 * 2; u.bB = Bt + ((size_t)e * 1024 + (size_t)pn * 256) * 256 * 2; u.nt = 4; return true;
    }
    __device__ __forceinline__ void wait_tiles(unsigned* ready, int wave) const {
        if (wave == 0) { for (int i = 0;; ++i) { const int d = unit_of(i); if (d < 0) break; unsigned* w = ready + 16 * (d >> 2); unsigned polls = 0;
            while ((unsigned)__builtin_amdgcn_readfirstlane(__hip_atomic_load(w, __ATOMIC_RELAXED, __HIP_MEMORY_SCOPE_AGENT)) < 16u && ++polls < (1u << 20)) __builtin_amdgcn_s_sleep(2); } }
        __syncthreads();
    }
};
__device__ __forceinline__ void compute_toffs(volatile LAS int* toffs, unsigned* cnt, int tid) {
    if (tid < 64) {
        const int c = (tid < 32) ? (int)__hip_atomic_load(cnt + tid, __ATOMIC_RELAXED, __HIP_MEMORY_SCOPE_AGENT) : 0;
        const int rem = c & 255, nrm = (c >> 8) + (rem > 128 ? 1 : 0), sml = (rem > 0 && rem <= 128) ? 1 : 0; int incl = nrm | (sml << 16);
#pragma unroll
        for (int o = 1; o < 32; o <<= 1) { const int v = __builtin_amdgcn_ds_bpermute((tid - o) << 2, incl); if (tid >= o) incl += v; }
        if (tid < 32) toffs[tid] = ((incl & 0xffff) - nrm) | (c << 8) | (((incl >> 16) - sml) << 23);
        if (tid == 31) toffs[32] = (incl & 0xffff) | ((incl >> 16) << 8);
    }
    __syncthreads();
}

template <bool FROM_SS> struct EpiProj {
    static constexpr bool PERM = true;
    bf16* O; const float* rstd;
    __device__ __forceinline__ void operator()(const gp::f32x4 (&acc)[2][2][4][2], const gp::Unit& u, int wr, int wc, int fr, int fq) const {
        const int row0 = u.pm * 256 + wr * 64 + fr, col0 = u.pn * 256 + wc * 32 + 8 * fq;
#pragma unroll
        for (int ai = 0; ai < 2; ++ai)
#pragma unroll
            for (int m = 0; m < 4; ++m) { const int row = row0 + ai * 128 + m * 16; float sc;
                if constexpr (FROM_SS) { const gp::f32x4 p4 = *(const gp::f32x4*)(rstd + (size_t)row * 16 + 4 * fq); float t = (p4[0] + p4[1]) + (p4[2] + p4[3]); t += swz_xor<16>(t); t = xor32_sum(t); sc = 1.0f / sqrtf(t * (1.0f / 1024.0f) + 1e-6f); }
                else sc = rstd[row];
                bf16* rowp = O + (size_t)row * LDP_ + col0;
#pragma unroll
                for (int bj = 0; bj < 2; ++bj) { const gp::f32x4 v0 = acc[ai][bj][m][0] * sc, v1 = acc[ai][bj][m][1] * sc;
                    gp::u32x4 w; w.x = gp::cvt_pk_bf16(v0[0], v0[1]); w.y = gp::cvt_pk_bf16(v0[2], v0[3]); w.z = gp::cvt_pk_bf16(v1[0], v1[1]); w.w = gp::cvt_pk_bf16(v1[2], v1[3]);
                    *(gp::u32x4*)(rowp + bj * 128) = w; } }
    }
};
struct EpiE {
    static constexpr bool PERM = true;
    bf16* O;
    __device__ __forceinline__ void operator()(const gp::f32x4 (&acc)[2][2][4][2], const gp::Unit& u, int wr, int wc, int fr, int fq) const {
        const int row0 = u.pm * 256 + wr * 64 + fr, col0 = u.pn * 256 + wc * 32 + 8 * fq;
#pragma unroll
        for (int ai = 0; ai < 2; ++ai)
#pragma unroll
            for (int m = 0; m < 4; ++m) { bf16* rowp = O + (size_t)(row0 + ai * 128 + m * 16) * 1024 + col0;
#pragma unroll
                for (int bj = 0; bj < 2; ++bj) { const gp::f32x4 v0 = acc[ai][bj][m][0], v1 = acc[ai][bj][m][1];
                    gp::u32x4 w; w.x = gp::cvt_pk_bf16(v0[0], v0[1]); w.y = gp::cvt_pk_bf16(v0[2], v0[3]); w.z = gp::cvt_pk_bf16(v1[0], v1[1]); w.w = gp::cvt_pk_bf16(v1[2], v1[3]);
                    *(gp::u32x4*)(rowp + bj * 128) = w; } }
    }
};
template <bool FROM_SS> struct EpiProjE {
    static constexpr bool PERM = true;
    EpiProj<FROM_SS> P; EpiE E;
    __device__ __forceinline__ void operator()(const gp::f32x4 (&acc)[2][2][4][2], const gp::Unit& u, int wr, int wc, int fr, int fq) const { if (u.aux) E(acc, u, wr, wc, fr, fq); else P(acc, u, wr, wc, fr, fq); }
};
struct EpiOut {
    static constexpr bool PERM = true;
    bf16* H;
    __device__ __forceinline__ void operator()(const gp::f32x4 (&acc)[2][2][4][2], const gp::Unit& u, int wr, int wc, int fr, int fq) const {
        const int row0 = u.pm * 256 + wr * 64 + fr, col0 = u.pn * 256 + wc * 32 + 8 * fq;
        gp::u32x4 p[2][4][2];
#pragma unroll
        for (int ai = 0; ai < 2; ++ai)
#pragma unroll
            for (int m = 0; m < 4; ++m)
#pragma unroll
                for (int bj = 0; bj < 2; ++bj) { const gp::f32x4 v0 = acc[ai][bj][m][0], v1 = acc[ai][bj][m][1];
                    p[ai][m][bj].x = gp::cvt_pk_bf16(v0[0], v0[1]); p[ai][m][bj].y = gp::cvt_pk_bf16(v0[2], v0[3]); p[ai][m][bj].z = gp::cvt_pk_bf16(v1[0], v1[1]); p[ai][m][bj].w = gp::cvt_pk_bf16(v1[2], v1[3]); }
        gp::u32x4 hb[2][4][2];
#pragma unroll
        for (int ai = 0; ai < 2; ++ai)
#pragma unroll
            for (int m = 0; m < 4; ++m)
#pragma unroll
                for (int bj = 0; bj < 2; ++bj) hb[ai][m][bj] = *(const gp::u32x4*)(H + (size_t)(row0 + ai * 128 + m * 16) * 1024 + col0 + bj * 128);
#pragma unroll
        for (int ai = 0; ai < 2; ++ai)
#pragma unroll
            for (int m = 0; m < 4; ++m)
#pragma unroll
                for (int bj = 0; bj < 2; ++bj) { const gp::u32x4 a = p[ai][m][bj], h = hb[ai][m][bj]; gp::u32x4 w;
#pragma unroll
                    for (int e = 0; e < 4; ++e) w[e] = gp::cvt_pk_bf16(bflo(h[e]) + bflo(a[e]), bfhi(h[e]) + bfhi(a[e]));
                    *(gp::u32x4*)(H + (size_t)(row0 + ai * 128 + m * 16) * 1024 + col0 + bj * 128) = w; }
    }
};
struct EpiUp {
    static constexpr bool PERM = true;
    bf16* HID; const float* rstd;
    __device__ __forceinline__ void operator()(const gp::f32x4 (&acc)[2][2][4][2], const gp::Unit& u, int wr, int wc, int fr, int fq) const {
        const int r0 = wr * 64 + fr, f0 = u.pn * 128 + wc * 32 + 8 * fq;
        float sc8[2][4], w8[2][4];
        { int lt8[2][4];
#pragma unroll
          for (int ai = 0; ai < 2; ++ai)
#pragma unroll
              for (int m = 0; m < 4; ++m) { const int r = r0 + ai * 128 + m * 16; const bool ok = r < u.aux; lt8[ai][m] = ok ? u.rl[r] : 0; w8[ai][m] = ok ? ((const float*)u.rl)[32 * VCAP + r] : 0.f; }
#pragma unroll
          for (int ai = 0; ai < 2; ++ai)
#pragma unroll
              for (int m = 0; m < 4; ++m) sc8[ai][m] = rstd[lt8[ai][m] >> 1]; }
#pragma unroll
        for (int ai = 0; ai < 2; ++ai)
#pragma unroll
            for (int m = 0; m < 4; ++m) { const int r = r0 + ai * 128 + m * 16, slot = u.pm * 256 + r; const float sc = sc8[ai][m], w = w8[ai][m];
                float h[8];
#pragma unroll
                for (int n = 0; n < 2; ++n)
#pragma unroll
                    for (int j = 0; j < 4; ++j) { const float a = acc[ai][0][m][n][j] * sc, b = acc[ai][1][m][n][j] * sc; h[4 * n + j] = a * fsigmoid(a) * b * w; }
                gp::u32x4 o; o.x = gp::cvt_pk_bf16(h[0], h[1]); o.y = gp::cvt_pk_bf16(h[2], h[3]); o.z = gp::cvt_pk_bf16(h[4], h[5]); o.w = gp::cvt_pk_bf16(h[6], h[7]);
                __builtin_amdgcn_raw_buffer_store_b128(o, __builtin_amdgcn_make_buffer_rsrc((void*)HID, 0, NSLOT * 512, 0x00020000), (slot * 256 + f0) * 2, 0, 16);
                asm volatile("" ::: "memory"); }
    }
};
struct EpiDown {
    static constexpr bool PERM = true;
    bf16* Y;
    __device__ __forceinline__ void operator()(const gp::f32x4 (&acc)[2][2][4][2], const gp::Unit& u, int wr, int wc, int fr, int fq) const {
        const int r0 = wr * 64 + fr, col0 = u.pn * 256 + wc * 32 + 8 * fq;
        int lt8[2][4];
#pragma unroll
        for (int ai = 0; ai < 2; ++ai)
#pragma unroll
            for (int m = 0; m < 4; ++m) { const int r = r0 + ai * 128 + m * 16; lt8[ai][m] = r < u.aux ? u.rl[r] : -1; }
        asm volatile("" ::: "memory");
#pragma unroll
        for (int ai = 0; ai < 2; ++ai)
#pragma unroll
            for (int m = 0; m < 4; ++m) { const int lt = lt8[ai][m];
                bf16* rowp = Y + (lt < 0 ? (size_t)2 * T_ : (size_t)(lt & 1) * T_ + (size_t)(lt >> 1)) * 1024 + col0;
#pragma unroll
                for (int bj = 0; bj < 2; ++bj) { const gp::f32x4 v0 = acc[ai][bj][m][0], v1 = acc[ai][bj][m][1];
                    gp::u32x4 w; w.x = gp::cvt_pk_bf16(v0[0], v0[1]); w.y = gp::cvt_pk_bf16(v0[2], v0[3]); w.z = gp::cvt_pk_bf16(v1[0], v1[1]); w.w = gp::cvt_pk_bf16(v1[2], v1[3]);
                    *(gp::u32x4*)(rowp + bj * 128) = w; }
                asm volatile("" ::: "memory"); }
    }
};
struct EpiPle {
    static constexpr bool PERM = true;
    const bf16* Hin; bf16* Hout; const bf16* Eb; const float* rstd; const float* bias; float* SS;
    __device__ __forceinline__ void operator()(const gp::f32x4 (&acc)[2][2][4][2], const gp::Unit& u, int wr, int wc, int fr, int fq) const {
        const int row0 = u.pm * 256 + wr * 64 + fr, col0 = u.pn * 256 + wc * 32 + 8 * fq;
        gp::u32x4 g[2][4][2];
        { gp::f32x4 bv[2][2]; float sc[2][4];
#pragma unroll
          for (int bj = 0; bj < 2; ++bj)
#pragma unroll
              for (int n = 0; n < 2; ++n) bv[bj][n] = *(const gp::f32x4*)(bias + col0 + bj * 128 + 4 * n);
#pragma unroll
          for (int ai = 0; ai < 2; ++ai)
#pragma unroll
              for (int m = 0; m < 4; ++m) sc[ai][m] = rstd[row0 + ai * 128 + m * 16];
#pragma unroll
          for (int ai = 0; ai < 2; ++ai)
#pragma unroll
              for (int m = 0; m < 4; ++m)
#pragma unroll
                  for (int bj = 0; bj < 2; ++bj) { const gp::f32x4 v0 = acc[ai][bj][m][0] * sc[ai][m] + bv[bj][0], v1 = acc[ai][bj][m][1] * sc[ai][m] + bv[bj][1];
                      g[ai][m][bj].x = gp::cvt_pk_bf16(fsigmoid(v0[0]), fsigmoid(v0[1])); g[ai][m][bj].y = gp::cvt_pk_bf16(fsigmoid(v0[2]), fsigmoid(v0[3]));
                      g[ai][m][bj].z = gp::cvt_pk_bf16(fsigmoid(v1[0]), fsigmoid(v1[1])); g[ai][m][bj].w = gp::cvt_pk_bf16(fsigmoid(v1[2]), fsigmoid(v1[3])); } }
#pragma unroll
        for (int ai = 0; ai < 2; ++ai) {
            gp::u32x4 hb[4][2], eb[4][2];
#pragma unroll
            for (int m = 0; m < 4; ++m)
#pragma unroll
                for (int bj = 0; bj < 2; ++bj) { const size_t off = (size_t)(row0 + ai * 128 + m * 16) * 1024 + col0 + bj * 128; hb[m][bj] = *(const gp::u32x4*)(Hin + off); eb[m][bj] = *(const gp::u32x4*)(Eb + off); }
#pragma unroll
            for (int m = 0; m < 4; ++m) { const int row = row0 + ai * 128 + m * 16; float ss = 0.f;
#pragma unroll
                for (int bj = 0; bj < 2; ++bj) { gp::u32x4 w;
#pragma unroll
                    for (int e = 0; e < 4; ++e) { w[e] = gp::cvt_pk_bf16(bflo(hb[m][bj][e]) + bflo(g[ai][m][bj][e]) * bflo(eb[m][bj][e]), bfhi(hb[m][bj][e]) + bfhi(g[ai][m][bj][e]) * bfhi(eb[m][bj][e]));
                        ss += bflo(w[e]) * bflo(w[e]) + bfhi(w[e]) * bfhi(w[e]); }
                    *(gp::u32x4*)(Hout + (size_t)row * 1024 + col0 + bj * 128) = w; }
                ss += swz_xor<16>(ss); ss = xor32_sum(ss);
                if (fq == 0) SS[(size_t)row * 16 + u.pn * 4 + wc] = ss; }
            asm volatile("" ::: "memory"); }
    }
};

struct EpiPleFinal {
    static constexpr bool PERM = true;
    const bf16* Hin; const bf16* Eb; const float* rstd; const float* bias; float* SS; unsigned* fin; const float* fg; float* out;
    __device__ __forceinline__ void operator()(const gp::f32x4 (&acc)[2][2][4][2], const gp::Unit& u, int wr, int wc, int fr, int fq) const {
        const int row0 = u.pm * 256 + wr * 64 + fr, col0 = u.pn * 256 + wc * 32 + 8 * fq;
        gp::u32x4 g[2][4][2];
        { gp::f32x4 bv[2][2]; float sc[2][4];
#pragma unroll
          for (int bj = 0; bj < 2; ++bj)
#pragma unroll
              for (int n = 0; n < 2; ++n) bv[bj][n] = *(const gp::f32x4*)(bias + col0 + bj * 128 + 4 * n);
#pragma unroll
          for (int ai = 0; ai < 2; ++ai)
#pragma unroll
              for (int m = 0; m < 4; ++m) sc[ai][m] = rstd[row0 + ai * 128 + m * 16];
#pragma unroll
          for (int ai = 0; ai < 2; ++ai)
#pragma unroll
              for (int m = 0; m < 4; ++m)
#pragma unroll
                  for (int bj = 0; bj < 2; ++bj) { const gp::f32x4 v0 = acc[ai][bj][m][0] * sc[ai][m] + bv[bj][0], v1 = acc[ai][bj][m][1] * sc[ai][m] + bv[bj][1];
                      g[ai][m][bj].x = gp::cvt_pk_bf16(fsigmoid(v0[0]), fsigmoid(v0[1])); g[ai][m][bj].y = gp::cvt_pk_bf16(fsigmoid(v0[2]), fsigmoid(v0[3]));
                      g[ai][m][bj].z = gp::cvt_pk_bf16(fsigmoid(v1[0]), fsigmoid(v1[1])); g[ai][m][bj].w = gp::cvt_pk_bf16(fsigmoid(v1[2]), fsigmoid(v1[3])); } }
        const auto ssrc = __builtin_amdgcn_make_buffer_rsrc((void*)SS, 0, T_ * 64, 0x00020000);
#pragma unroll
        for (int ai = 0; ai < 2; ++ai) {
            gp::u32x4 hb[4][2], eb[4][2];
#pragma unroll
            for (int m = 0; m < 4; ++m)
#pragma unroll
                for (int bj = 0; bj < 2; ++bj) { const size_t off = (size_t)(row0 + ai * 128 + m * 16) * 1024 + col0 + bj * 128; hb[m][bj] = *(const gp::u32x4*)(Hin + off); eb[m][bj] = *(const gp::u32x4*)(Eb + off); }
#pragma unroll
            for (int m = 0; m < 4; ++m) { const int row = row0 + ai * 128 + m * 16; float ss = 0.f;
#pragma unroll
                for (int bj = 0; bj < 2; ++bj) { gp::u32x4 w;
#pragma unroll
                    for (int e = 0; e < 4; ++e) { w[e] = gp::cvt_pk_bf16(bflo(hb[m][bj][e]) + bflo(g[ai][m][bj][e]) * bflo(eb[m][bj][e]), bfhi(hb[m][bj][e]) + bfhi(g[ai][m][bj][e]) * bfhi(eb[m][bj][e]));
                        ss += bflo(w[e]) * bflo(w[e]) + bfhi(w[e]) * bfhi(w[e]); }
                    g[ai][m][bj] = w; }
                ss += swz_xor<16>(ss); ss = xor32_sum(ss);
                if (fq == 0) __builtin_amdgcn_raw_buffer_store_b32(__float_as_uint(ss), ssrc, (row * 16 + u.pn * 4 + wc) * 4, 0, 16); }
            asm volatile("" ::: "memory"); }
        asm volatile("s_waitcnt vmcnt(0)" ::: "memory");
        unsigned* w = fin + 16 * u.pm;
        if (hw_lane() == 0) __hip_atomic_fetch_add(w, 1u, __ATOMIC_RELAXED, __HIP_MEMORY_SCOPE_AGENT);
        { unsigned polls = 0; while ((unsigned)__builtin_amdgcn_readfirstlane(__hip_atomic_load(w, __ATOMIC_RELAXED, __HIP_MEMORY_SCOPE_AGENT)) < 32u && ++polls < (1u << 20)) __builtin_amdgcn_s_sleep(2); }
        float rs[2][4];
#pragma unroll
        for (int ai = 0; ai < 2; ++ai)
#pragma unroll
            for (int m = 0; m < 4; ++m) { const int row = row0 + ai * 128 + m * 16;
                const gp::u32x4 p = __builtin_amdgcn_raw_buffer_load_b128(ssrc, (row * 16 + 4 * fq) * 4, 0, 17);
                float t = (__uint_as_float(p.x) + __uint_as_float(p.y)) + (__uint_as_float(p.z) + __uint_as_float(p.w));
                t += swz_xor<16>(t); t = xor32_sum(t);
                rs[ai][m] = 1.0f / sqrtf(t * (1.0f / 1024.0f) + 1e-6f); }
        gp::f32x4 gv[2][2];
#pragma unroll
        for (int bj = 0; bj < 2; ++bj)
#pragma unroll
            for (int n = 0; n < 2; ++n) gv[bj][n] = *(const gp::f32x4*)(fg + col0 + bj * 128 + 4 * n);
#pragma unroll
        for (int ai = 0; ai < 2; ++ai)
#pragma unroll
            for (int m = 0; m < 4; ++m) { const float r = rs[ai][m]; float* op = out + (size_t)(row0 + ai * 128 + m * 16) * 1024 + col0;
#pragma unroll
                for (int bj = 0; bj < 2; ++bj) { const gp::u32x4 h = g[ai][m][bj];
                    *(gp::f32x4*)(op + bj * 128) = (gp::f32x4){bflo(h.x) * r * gv[bj][0][0], bfhi(h.x) * r * gv[bj][0][1], bflo(h.y) * r * gv[bj][0][2], bfhi(h.y) * r * gv[bj][0][3]};
                    *(gp::f32x4*)(op + bj * 128 + 4) = (gp::f32x4){bflo(h.z) * r * gv[bj][1][0], bfhi(h.z) * r * gv[bj][1][1], bflo(h.w) * r * gv[bj][1][2], bfhi(h.w) * r * gv[bj][1][3]}; } }
    }
};

__device__ __forceinline__ void router_phase(LAS unsigned char* lds, const bf16* H, const bf16* WRT, const float* rg_b, const float* re_b, float* RSTD2, int* VTOK, float* VW, unsigned* cnt,
                                             const int vcu, const int G, const int wave, const int lane, const int tid) {
    typedef short bf16x8 __attribute__((ext_vector_type(8))); typedef float f32x16 __attribute__((ext_vector_type(16)));
    LAS float* part = (LAS float*)lds;
    LAS float* ssqp = (LAS float*)(lds + 40960);
    LAS unsigned* hist = (LAS unsigned*)(lds + 40960 + 1024);
    LAS unsigned* base = hist + 32;
    const int r = lane & 31, hh = lane >> 5, item = wave >> 2, kq = wave & 3;
    LAS float* biasl = (LAS float*)(lds + 40960 + 1024 + 256);
    if (tid < 36) biasl[tid] = (tid < 4) ? rg_b[tid] : re_b[tid - 4];
    for (int tb = vcu; tb < T_ / 64; tb += G) {
        __syncthreads();
        if (tid < 32) hist[tid] = 0u;
        const size_t t_base = (size_t)tb * 64 + 32 * item;
        f32x16 acc[4];
#pragma unroll
        for (int nb = 0; nb < 4; ++nb)
#pragma unroll
            for (int i = 0; i < 16; ++i) acc[nb][i] = 0.f;
        float ssq = 0.f;
        const bf16* ap = H + (t_base + r) * 1024 + 256 * kq + 8 * hh; const bf16* bp = WRT + (size_t)r * 1024 + 256 * kq + 8 * hh;
        v4u an[4];
#pragma unroll
        for (int q = 0; q < 4; ++q) an[q] = *(const v4u*)(ap + 16 * q);
#pragma unroll 1
        for (int s0 = 0; s0 < 16; s0 += 4) {
            v4u ac[4];
#pragma unroll
            for (int q = 0; q < 4; ++q) ac[q] = an[q];
            if (s0 + 4 < 16) {
#pragma unroll
                for (int q = 0; q < 4; ++q) an[q] = *(const v4u*)(ap + 16 * (s0 + 4 + q)); }
#pragma unroll
            for (int q = 0; q < 4; ++q) { const int s = s0 + q;
                const v4u araw = ac[q];
#pragma unroll
                for (int e = 0; e < 4; ++e) { const float x0 = bflo(araw[e]), x1 = bfhi(araw[e]); ssq += x0 * x0 + x1 * x1; }
                const bf16x8 af = __builtin_bit_cast(bf16x8, araw);
#pragma unroll
                for (int nb = 0; nb < 4; ++nb) { const bf16x8 bfr = *(const bf16x8*)(bp + (size_t)32 * nb * 1024 + 16 * s); acc[nb] = __builtin_amdgcn_mfma_f32_32x32x16_bf16(af, bfr, acc[nb], 0, 0, 0); }
            }
        }
#pragma unroll
        for (int i = 0; i < 16; ++i) { const int tk = (i & 3) + 8 * (i >> 2) + 4 * hh; LAS float* p = part + (wave * 32 + tk) * 40;
            p[r] = acc[0][i] + acc[1][i]; if (r < 4) p[32 + r] = acc[2][i] + acc[3][i]; }
        ssq += __uint_as_float(__builtin_amdgcn_permlane32_swap(__float_as_uint(ssq), __float_as_uint(ssq), false, false)[hh ? 0 : 1]);
        if (hh == 0) ssqp[wave * 32 + r] = ssq;
        __syncthreads();
        int ea = 0, eb = 0; float wa = 0.f, wb = 0.f, rs = 0.f; unsigned ra = 0u, rb = 0u;
        if (tid < 64) {
            const int it = tid >> 5, tk = tid & 31;
            float lg36[36]; float ss = 0.f;
#pragma unroll
            for (int j = 0; j < 36; ++j) lg36[j] = 0.f;
#pragma unroll
            for (int w4 = 0; w4 < 4; ++w4) { const LAS float* p = part + ((it * 4 + w4) * 32 + tk) * 40; ss += ssqp[(it * 4 + w4) * 32 + tk];
#pragma unroll
                for (int q = 0; q < 9; ++q) { const f32x4 v = *(const LAS f32x4*)(p + 4 * q); lg36[4 * q] += v.x; lg36[4 * q + 1] += v.y; lg36[4 * q + 2] += v.z; lg36[4 * q + 3] += v.w; } }
            rs = 1.0f / sqrtf(ss * (1.0f / 1024.0f) + 1e-6f);
            float lg[4];
#pragma unroll
            for (int j = 0; j < 4; ++j) lg[j] = lg36[j] * rs + biasl[j];
            int gi = 0; float gm = lg[0];
#pragma unroll
            for (int j = 1; j < 4; ++j) if (lg[j] > gm) { gm = lg[j]; gi = j; }
            float gs = 0.f;
#pragma unroll
            for (int j = 0; j < 4; ++j) gs += expf(lg[j] - gm);
            const float gwt = 1.0f / gs;
            float el[8];
#pragma unroll
            for (int j = 0; j < 8; ++j) { float v = lg36[4 + j]; float bb = biasl[4 + j];
#pragma unroll
                for (int g = 1; g < 4; ++g) { v = (gi == g) ? lg36[4 + 8 * g + j] : v; bb = (gi == g) ? biasl[4 + 8 * g + j] : bb; }
                el[j] = v * rs + bb; }
            int i0 = 0; float m0 = el[0];
#pragma unroll
            for (int j = 1; j < 8; ++j) if (el[j] > m0) { m0 = el[j]; i0 = j; }
            int i1 = -1; float m1 = -INFINITY;
#pragma unroll
            for (int j = 0; j < 8; ++j) if (j != i0 && el[j] > m1) { m1 = el[j]; i1 = j; }
            const float e1 = expf(m1 - m0); wa = gwt / (1.0f + e1); wb = gwt * e1 / (1.0f + e1);
            ea = gi * 8 + i0; eb = gi * 8 + i1;
            ra = __hip_atomic_fetch_add(hist + ea, 1u, __ATOMIC_RELAXED, __HIP_MEMORY_SCOPE_WORKGROUP); rb = __hip_atomic_fetch_add(hist + eb, 1u, __ATOMIC_RELAXED, __HIP_MEMORY_SCOPE_WORKGROUP);
        }
        __syncthreads();
        if (tid < 32) { const unsigned c = hist[tid]; base[tid] = c ? __hip_atomic_fetch_add(cnt + tid, c, __ATOMIC_RELAXED, __HIP_MEMORY_SCOPE_AGENT) : 0u; }
        __syncthreads();
        if (tid < 64) { const size_t t = (size_t)tb * 64 + tid;
            const size_t sa = (size_t)ea * VCAP + base[ea] + ra, sb_ = (size_t)eb * VCAP + base[eb] + rb;
            RSTD2[t] = rs; VTOK[sa] = (int)(2 * t); VW[sa] = wa; VTOK[sb_] = (int)(2 * t + 1); VW[sb_] = wb; }
    }
}
__device__ __forceinline__ void combine_phase(bf16* H, const bf16* Y, float* RSTD3, int gw, int NGW, int lane) {
    for (int t = gw; t < T_; t += NGW) {
        v4u* hr = (v4u*)(H + (size_t)t * 1024) + lane; const v4u* y0 = (const v4u*)(Y + (size_t)t * 1024) + lane; const v4u* y1 = (const v4u*)(Y + ((size_t)T_ + t) * 1024) + lane; float ss = 0.f;
#pragma unroll
        for (int j = 0; j < 2; ++j) { const v4u h = hr[64 * j], a = y0[64 * j], b = y1[64 * j]; v4u o;
#pragma unroll
            for (int e = 0; e < 4; ++e) { o[e] = pk2(bflo(h[e]) + bflo(a[e]) + bflo(b[e]), bfhi(h[e]) + bfhi(a[e]) + bfhi(b[e])); ss += bflo(o[e]) * bflo(o[e]) + bfhi(o[e]) * bfhi(o[e]); }
            hr[64 * j] = o; }
        ss = wave_sum(ss); if (lane == 0) RSTD3[t] = 1.0f / sqrtf(ss * (1.0f / 1024.0f) + 1e-6f);
    }
}
__device__ __forceinline__ void final_phase(const bf16* H, float* out, const float* g, int gw, int NGW, int lane) {
    for (int t = gw; t < T_; t += NGW) {
        const v4u* hr = (const v4u*)(H + (size_t)t * 1024) + lane; v4u v[2]; float ss = 0.f;
#pragma unroll
        for (int j = 0; j < 2; ++j) { v[j] = hr[64 * j];
#pragma unroll
            for (int e = 0; e < 4; ++e) ss += bflo(v[j][e]) * bflo(v[j][e]) + bfhi(v[j][e]) * bfhi(v[j][e]); }
        ss = wave_sum(ss); const float rs = 1.0f / sqrtf(ss * (1.0f / 1024.0f) + 1e-6f);
        f32x4* o = (f32x4*)(out + (size_t)t * 1024);
#pragma unroll
        for (int j = 0; j < 2; ++j) { const int c8 = 64 * j + lane; const f32x4 g0 = ((const f32x4*)g)[2 * c8], g1 = ((const f32x4*)g)[2 * c8 + 1];
            o[2 * c8] = (f32x4){bflo(v[j][0]) * rs * g0.x, bfhi(v[j][0]) * rs * g0.y, bflo(v[j][1]) * rs * g0.z, bfhi(v[j][1]) * rs * g0.w};
            o[2 * c8 + 1] = (f32x4){bflo(v[j][2]) * rs * g1.x, bfhi(v[j][2]) * rs * g1.y, bflo(v[j][3]) * rs * g1.z, bfhi(v[j][3]) * rs * g1.w}; }
    }
}
struct MArgs { const float* in[23]; float* out; unsigned char* ws; };
__device__ __forceinline__ void* lds_ptr(LAS unsigned char* lds, int i) {
    unsigned off = LDS_MISC + 512; asm volatile("" : "+v"(off));
    const volatile LAS unsigned* q = (const volatile LAS unsigned*)(lds + off) + 2 * i;
    const unsigned lo = __builtin_amdgcn_readfirstlane(q[0]), hi = __builtin_amdgcn_readfirstlane(q[1]);
    typedef __attribute__((address_space(1))) char gchar;
    return (void*)(gchar*)(((unsigned long long)hi << 32) | lo);
}

#define ARGP(i) ((const float*)lds_ptr(lds, (i)))
#define WSP() ((unsigned char*)lds_ptr(lds, 24))
#define HFP() ((float*)lds_ptr(lds, 23))
#define PHASE_IDS() const int lane = hw_lane(); const int tid = wave * 64 + lane; const int gw = vcu * NWAVES + wave; const int gtid = (int)blockIdx.x * NTHREADS + tid; (void)lane; (void)gw; (void)gtid
template <int l> __device__ __forceinline__ void layer_body(LAS unsigned char* lds, const XcdBarrier& bar, volatile LAS int* toffs, const int wave, const int vcu, const int G) {
    constexpr long T = T_; constexpr int D = 1024, DPROJ = 2576, PLE = 256, NE = 32, DE = 256;
    const int NGW = G * NWAVES, GT = G * NTHREADS;
#define LAYER_PTRS() unsigned char* ws = WSP(); bf16* Ha = (bf16*)(ws + OFF_HB) + (size_t)(l & 1) * T_ * 1024; bf16* Hb = (bf16*)(ws + OFF_HB) + (size_t)((l + 1) & 1) * T_ * 1024; unsigned* cnt = (unsigned*)ws + CW_CNT + 64 * l; unsigned* fill = (unsigned*)ws + CW_FILL + 64 * l; \
        float* RSTD1 = (float*)(ws + OFF_RSTD); float* RSTD2 = RSTD1 + T_; float* RSTD3 = RSTD2 + T_; (void)Ha; (void)Hb; (void)cnt; (void)fill; (void)RSTD1; (void)RSTD2; (void)RSTD3
        if constexpr (l == 0) {
        { PHASE_IDS(); LAYER_PTRS();
          LayerIn I; I.x = ARGP(0); I.pl = ARGP(1) + (size_t)l * T * PLE; I.norm1_g = ARGP(2) + (size_t)l * D; I.w_in = ARGP(3) + (size_t)l * D * DPROJ; I.w_out = ARGP(9) + (size_t)l * D * D; I.norm2_g = ARGP(10) + (size_t)l * D;
          I.rg_w = ARGP(11) + (size_t)l * D * 4; I.re_w = ARGP(13) + (size_t)l * D * 32; I.wg = ARGP(15) + (size_t)l * NE * D * DE; I.wu = ARGP(16) + (size_t)l * NE * D * DE; I.wd = ARGP(17) + (size_t)l * NE * DE * D;
          I.ple_g = ARGP(18) + (size_t)l * D; I.ple_w = ARGP(19) + (size_t)l * D * D; I.ple_p = ARGP(21) + (size_t)l * PLE * D; I.pool_w = ARGP(7) + (size_t)l * 4 * 64 * 64;
          int GT_ = GT, NGW_ = NGW; asm volatile("" : "+s"(GT_), "+s"(NGW_));
          prologue_phase<0>(lds, I, ws, (unsigned char*)HFP(), l, gw, NGW_, wave, lane, gtid, GT_); }
        xcd_barrier(bar);
        }
        { LAYER_PTRS(); ProjESched S; S.init(Ha, ws + OFF_WIN, (unsigned char*)HFP() + OB_PB, (unsigned char*)HFP() + OB_WPP, G, (int)blockIdx.x);
          EpiProjE<(l > 0)> E{EpiProj<(l > 0)>{(bf16*)(ws + OFF_PROJ), (l > 0) ? (const float*)(ws + OFF_SS) : RSTD1}, EpiE{(bf16*)(ws + OFF_EB)}};
          gp::gemm_phase<EpiProjE<(l > 0)>, ProjESched>(lds, S, E, 1024, 1024, wave); }
        xcd_barrier(bar);
        { PHASE_IDS(); LAYER_PTRS();
          gla::G1Args ga{(const bf16*)(ws + OFF_PROJ), ARGP(4) + (size_t)l * 16 * 192, ARGP(5) + (size_t)l * 192, (bf16*)(ws + OFF_QD), (bf16*)(ws + OFF_KI), (float*)(ws + OFF_KVT), (float*)(ws + OFF_DEC),
                         (const bf16*)(ws + OFF_WPL), ARGP(8) + (size_t)l * 256, (bf16*)(ws + OFF_MIX)};
          gla::gla1_phase<false>(lds, ga, vcu, G, wave, lane, tid);
          __syncthreads();
          sb::sb_phase(lds, (const bf16*)(ws + OFF_PROJ), (bf16*)(ws + OFF_MIX), vcu, G, wave, lane);
          if (wave >= 4) for (int ch = vcu; ch < 256; ch += G)
              gla::pool_wave(lds + wave * sb::VT_BYTES, lds + 8 * sb::VT_BYTES + (wave - 4) * (64 * gla::UST), (const bf16*)(ws + OFF_PROJ), (const bf16*)(ws + OFF_WPL), ARGP(8) + (size_t)l * 256, (bf16*)(ws + OFF_MIX), ch, wave - 4, lane); }
        xcd_barrier(bar);
        { PHASE_IDS(); LAYER_PTRS(); gla::gla2_phase((const float*)(ws + OFF_KVT), (const float*)(ws + OFF_DEC), (bf16*)(ws + OFF_STB), gtid, GT); }
        xcd_barrier(bar);
        { PHASE_IDS(); LAYER_PTRS();
          gla::G3Args ga{(const bf16*)(ws + OFF_PROJ), (const bf16*)(ws + OFF_QD), (const bf16*)(ws + OFF_KI), (const bf16*)(ws + OFF_STB), ARGP(6) + (size_t)l * 96, (bf16*)(ws + OFF_MIX)};
          gla::gla3_phase(lds, ga, vcu, G, wave, lane, tid); }
        xcd_barrier(bar);
        { LAYER_PTRS(); PlainSched S; S.init(ws + OFF_MIX, ws + OFF_WOUT, T_, 1024, 1024, 1024, 1024, G, (int)blockIdx.x);
          EpiOut E{Ha};
          gp::gemm_phase<EpiOut, PlainSched>(lds, S, E, 1024, 1024, wave); }
        xcd_barrier(bar);
        { PHASE_IDS(); LAYER_PTRS(); router_phase(lds, Ha, (const bf16*)(ws + OFF_WR), ARGP(12) + (size_t)l * 4, ARGP(14) + (size_t)l * 32, RSTD2, (int*)(ws + OFF_VTOK), (float*)(ws + OFF_VW), cnt, vcu, G, wave, lane, tid); }
        xcd_barrier(bar);
        { PHASE_IDS(); LAYER_PTRS(); compute_toffs(toffs, cnt, tid); }
        { LAYER_PTRS(); MoeUpSched S; S.toffs = toffs; S.G = G; S.c = vcu  ; S.A = (const char*)Ha; S.Bt = (const char*)(ws + OFF_WGU); S.lrow = (const int*)(ws + OFF_VTOK); S.ready = (unsigned*)ws + CW_RDY + 4096 * l;
          EpiUp E{(bf16*)(ws + OFF_HID), RSTD2};
          gp::gemm_phase<EpiUp, MoeUpSched>(lds, S, E, 1024, 1024, wave); }
        { LAYER_PTRS(); MoeDownSched<false> S; S.toffs = toffs; S.G = G; S.c = vcu  ; S.A = (const char*)(ws + OFF_HID); S.Bt = (const char*)(ws + OFF_WD); S.vtok = (const int*)(ws + OFF_VTOK);
          S.wait_tiles((unsigned*)ws + CW_RDY + 4096 * l, wave);
          EpiDown E{(bf16*)(ws + OFF_Y)};
          gp::gemm_phase<EpiDown, MoeDownSched<false>>(lds, S, E, 256, 256, wave); }
        { LAYER_PTRS(); MoeDownSched<true> S; S.toffs = toffs; S.G = G; S.c = vcu  ; S.A = (const char*)(ws + OFF_HID); S.Bt = (const char*)(ws + OFF_WD); S.vtok = (const int*)(ws + OFF_VTOK);
          S.wait_tiles((unsigned*)ws + CW_RDY + 4096 * l, wave);
          EpiDown E{(bf16*)(ws + OFF_Y)};
          gp::gemm_phase<EpiDown, MoeDownSched<true>>(lds, S, E, 256, 256, wave); }
        xcd_barrier(bar);
        { PHASE_IDS(); LAYER_PTRS(); combine_phase(Ha, (const bf16*)(ws + OFF_Y), RSTD3, gw, NGW, lane); }
        if constexpr (l == 0) {
          PHASE_IDS(); LAYER_PTRS(); constexpr int ln = l + 1;
          LayerIn I; I.x = ARGP(0); I.pl = ARGP(1) + (size_t)ln * T * PLE; I.norm1_g = ARGP(2) + (size_t)ln * D; I.w_in = ARGP(3) + (size_t)ln * D * DPROJ; I.w_out = ARGP(9) + (size_t)ln * D * D; I.norm2_g = ARGP(10) + (size_t)ln * D;
          I.rg_w = ARGP(11) + (size_t)ln * D * 4; I.re_w = ARGP(13) + (size_t)ln * D * 32; I.wg = ARGP(15) + (size_t)ln * NE * D * DE; I.wu = ARGP(16) + (size_t)ln * NE * D * DE; I.wd = ARGP(17) + (size_t)ln * NE * DE * D;
          I.ple_g = ARGP(18) + (size_t)ln * D; I.ple_w = ARGP(19) + (size_t)ln * D * D; I.ple_p = ARGP(21) + (size_t)ln * PLE * D; I.pool_w = ARGP(7) + (size_t)ln * 4 * 64 * 64;
          int GT_ = GT, NGW_ = NGW; asm volatile("" : "+s"(GT_), "+s"(NGW_));
          prologue_phase<1>(lds, I, ws, (unsigned char*)HFP(), ln, gw, NGW_, wave, lane, gtid, GT_); }
        xcd_barrier(bar);
        if constexpr (l == 0) {
          { LAYER_PTRS(); PlainSched S; S.init(Ha, ws + ((l & 1) ? OFF_PB : OFF_WPG), T_, 1024, 1024, 1024, 1024, G, (int)blockIdx.x);
            EpiPle E{Ha, Hb, (const bf16*)(ws + OFF_EB), RSTD3, ARGP(20) + (size_t)l * D, (float*)(ws + OFF_SS)};
            gp::gemm_phase<EpiPle, PlainSched>(lds, S, E, 1024, 1024, wave); }
          xcd_barrier(bar);
        } else {
          { LAYER_PTRS(); PlainSched S; S.init(Ha, ws + ((l & 1) ? OFF_PB : OFF_WPG), T_, 1024, 1024, 1024, 1024, G, (int)blockIdx.x);
            EpiPleFinal E{Ha, (const bf16*)(ws + OFF_EB), RSTD3, ARGP(20) + (size_t)l * D, (float*)(ws + OFF_SS), (unsigned*)ws + CW_FIN, ARGP(22), HFP()};
            gp::gemm_phase<EpiPleFinal, PlainSched>(lds, S, E, 1024, 1024, wave); }
        }
#undef LAYER_PTRS

}
__global__ void __launch_bounds__(NTHREADS, 2) mega_fwd(MArgs a) {
    extern __shared__ __attribute__((aligned(16))) unsigned char lds_raw[];
    LAS unsigned char* lds = (LAS unsigned char*)lds_raw;
    volatile LAS unsigned* misc = (volatile LAS unsigned*)(lds + LDS_MISC);
    volatile LAS int* toffs = (volatile LAS int*)(lds + LDS_MISC + 256);
    if (threadIdx.x < 16) misc[threadIdx.x] = 0u;
    __syncthreads();
    const XcdBarrier bar = xcd_barrier_post((unsigned*)a.ws, misc);
    const int wave = __builtin_amdgcn_readfirstlane(threadIdx.x >> 6);
    const int G = gridDim.x; const int vcu = (G % 8 == 0) ? ((int)blockIdx.x % 8) * (G / 8) + (int)blockIdx.x / 8 : (int)blockIdx.x;
    if (threadIdx.x < 25) ((volatile LAS unsigned long long*)(lds + LDS_MISC + 512))[threadIdx.x] = (threadIdx.x < 23) ? (unsigned long long)a.in[threadIdx.x < 23 ? threadIdx.x : 0] : (threadIdx.x == 23 ? (unsigned long long)a.out : (unsigned long long)a.ws);
    __syncthreads();
    const int NGW = G * NWAVES; (void)NGW;
    layer_body<0>(lds, bar, toffs, wave, vcu, G);
    layer_body<1>(lds, bar, toffs, wave, vcu, G);
#undef PHASE_IDS
#undef ARGP
#undef WSP
#undef HFP
}

extern "C" void kernel_launch(void* const* d_in, const int* in_sizes, int n_in, void* d_out, int out_size, void* d_ws, size_t ws_size, hipStream_t stream) {
    static int grid = 0;
    if (grid == 0) {
        int dev = 0, cus = 0, per_cu = 0;
        if (hipGetDevice(&dev) != hipSuccess || hipDeviceGetAttribute(&cus, hipDeviceAttributeMultiprocessorCount, dev) != hipSuccess) { grid = -1; return; }
        if (hipFuncSetAttribute((const void*)mega_fwd, hipFuncAttributeMaxDynamicSharedMemorySize, LDS_BYTES) != hipSuccess) { fprintf(stderr, "kernel_launch: hipFuncSetAttribute failed\n"); grid = -1; return; }
        if (hipOccupancyMaxActiveBlocksPerMultiprocessor(&per_cu, (const void*)mega_fwd, NTHREADS, LDS_BYTES) != hipSuccess || per_cu < 1) { fprintf(stderr, "kernel_launch: occupancy query says %d blocks per CU\n", per_cu); (void)hipGetLastError(); grid = -1; return; }
        grid = cus;
        if (WS_END > ws_size) { fprintf(stderr, "kernel_launch: workspace too small: need %zu have %zu\n", (size_t)WS_END, ws_size); grid = -1; return; }
    }
    if (grid < 0) return;
    if (hipMemsetAsync(d_ws, 0, CTL_BYTES, stream) != hipSuccess) return;
    MArgs a{};
    for (int i = 0; i < 23; ++i) a.in[i] = (const float*)d_in[i];
    a.out = (float*)d_out; a.ws = (unsigned char*)d_ws;
    hipLaunchKernelGGL(mega_fwd, dim3(grid), dim3(NTHREADS), LDS_BYTES, stream, a);
}
```

```cpp
#include <hip/hip_runtime.h>
#include <cstdio>
#include <cstdint>
#include <math.h>
#define LAS __attribute__((address_space(3)))
namespace gp {
typedef unsigned short bf16_t;
typedef short bf16x8 __attribute__((ext_vector_type(8)));
typedef float f32x4 __attribute__((ext_vector_type(4)));
typedef unsigned u32x4 __attribute__((ext_vector_type(4)));
typedef unsigned u32x2 __attribute__((ext_vector_type(2)));
constexpr int BM = 256, BK = 64, HALF = 128, HTB = HALF * BK * 2, STAGE_BYTES = 8 * HTB;

__host__ __device__ __forceinline__ int lds_byte(int r, int c) { const int st = (r >> 4) * 2 + (c >> 5), rr = r & 15, cc = c & 31, ob = rr * 64 + cc * 2; return st * 1024 + (ob ^ (((ob >> 9) & 1) << 5)); }
__host__ __device__ __forceinline__ void stage_rc(int b, int& R, int& C) { const int st = b / 1024, sb = b % 1024, swz = sb ^ (((sb >> 9) & 1) << 5); R = (st >> 1) * 16 + swz / 64; C = (st & 1) * 32 + (swz % 64) / 2; }
__host__ __device__ __forceinline__ int perm32(int rho) { const int n = rho >> 4, i = rho & 15; return 8 * (i >> 2) + 4 * n + (i & 3); }
__device__ __forceinline__ unsigned cvt_pk_bf16(float lo, float hi) { typedef float f2_ __attribute__((ext_vector_type(2))); typedef __bf16 b2_ __attribute__((ext_vector_type(2))); const f2_ v_ = {lo, hi}; return __builtin_bit_cast(unsigned, __builtin_convertvector(v_, b2_)); }

__device__ __forceinline__ const char* rfl_ptr(const char* p) {
    const unsigned long long v = (unsigned long long)p; const unsigned lo = __builtin_amdgcn_readfirstlane((unsigned)v), hi = __builtin_amdgcn_readfirstlane((unsigned)(v >> 32)); return (const char*)(((unsigned long long)hi << 32) | lo); }
struct Unit { int pm, pn; const char* aB; const char* bB; int nt; const int* rl; int aux; };

template <class Epi, class Sched>
__device__ __forceinline__ void gemm_phase(LAS unsigned char* lds, const Sched& S, const Epi& E, const int lda  , const int ldb  , const int wid  ) {
    unsigned m_ = ~0u; asm volatile("" : "+s"(m_)); const int lane0 = (int)__builtin_amdgcn_mbcnt_hi(m_, __builtin_amdgcn_mbcnt_lo(m_, 0u));
    const int tid = wid * 64 + lane0, lane = tid & 63, wr = wid >> 2, wc = wid & 3, fr = lane & 15, fq = lane >> 4;
    unsigned voffA[2], voffB[2];
#pragma unroll
    for (int i = 0; i < 2; ++i) { int R, C; stage_rc(tid * 16 + i * 8192, R, C); const int Rb = Epi::PERM ? ((R & ~31) + perm32(R & 31)) : R; voffB[i] = (unsigned)(Rb * ldb + C) * 2u;
        voffA[i] = Sched::GATHER ? (unsigned)(R | (C << 16)) : (unsigned)(R * lda + C) * 2u; }
    const size_t hstepA = Sched::GATHER ? 0 : (size_t)HALF * lda * 2;
    const size_t kstep = (size_t)(BK * 2);
    const size_t hstepB = (size_t)HALF * ldb * 2;
    const unsigned ldsw = (unsigned)wid * 1024u;
    const int aoff = lds_byte(wr * 64 + fr, fq * 8), boff = lds_byte(wc * 32 + fr, fq * 8);
    unsigned ac[2], an[2];
#define GP_AOFF(dst, u) do { if constexpr (Sched::GATHER) { _Pragma("unroll") for (int _h = 0; _h < 2; ++_h) \
        dst[_h] = S.arow((u), _h * HALF + (int)(voffA[0] & 0xffffu)) | (S.arow((u), _h * HALF + (int)(voffA[1] & 0xffffu)) << 16); } } while (0)
#define GP_STAGE_A(bufoff, kp, h, which) do { if constexpr (Sched::GATHER) { const unsigned _p = ((which) && last) ? an[h] : ac[h]; \
        const unsigned _o0 = (_p & 0xffffu) * (unsigned)(lda * 2) + (voffA[0] >> 16) * 2u, _o1 = (_p >> 16) * (unsigned)(lda * 2) + (voffA[1] >> 16) * 2u; GP_STAGE(bufoff, kp, _o0, _o1); } \
        else GP_STAGE(bufoff, (kp) + (h) * hstepA, voffA[0], voffA[1]); } while (0)
#define GP_SA(b, h) (((b) * 2 + (h)) * HTB)
#define GP_SB(b, h) ((4 + (b) * 2 + (h)) * HTB)
#define GP_STAGE(bufoff, gbase, o0, o1) do { \
        __builtin_amdgcn_global_load_lds((const unsigned*)((const char*)(gbase) + (o0)), (LAS unsigned*)(lds + (bufoff) + ldsw), 16, 0, 0); \
        __builtin_amdgcn_global_load_lds((const unsigned*)((const char*)(gbase) + (o1)), (LAS unsigned*)(lds + (bufoff) + ldsw + 8192), 16, 0, 0); } while (0)
#define GP_LDA(dst, b, h) do { _Pragma("unroll") for (int m = 0; m < 4; ++m) _Pragma("unroll") for (int k = 0; k < 2; ++k) dst[m][k] = *(const LAS bf16x8*)(lds + GP_SA(b, h) + aoff + m * 2048 + k * 1024); } while (0)
#define GP_LDB(dst, b, h) do { _Pragma("unroll") for (int n = 0; n < 2; ++n) _Pragma("unroll") for (int k = 0; k < 2; ++k) dst[n][k] = *(const LAS bf16x8*)(lds + GP_SB(b, h) + boff + n * 2048 + k * 1024); } while (0)
#define GP_MMA(ai, bj, At, Bt) do { __builtin_amdgcn_s_setprio(1); _Pragma("unroll") for (int m = 0; m < 4; ++m) _Pragma("unroll") for (int n = 0; n < 2; ++n) _Pragma("unroll") for (int k = 0; k < 2; ++k) \
        acc[ai][bj][m][n] = __builtin_amdgcn_mfma_f32_16x16x32_bf16(Bt[n][k], At[m][k], acc[ai][bj][m][n], 0, 0, 0); __builtin_amdgcn_s_setprio(0); } while (0)
#define GP_WAIT_V(n) asm volatile("s_waitcnt vmcnt(" #n ")" ::: "memory")
#define GP_WAIT_L(n) asm volatile("s_waitcnt lgkmcnt(" #n ")" ::: "memory")
#define GP_BAR __builtin_amdgcn_s_barrier()
#define GP_SCHED __builtin_amdgcn_sched_barrier(0)
    Unit cur, nxt; int ui = 0;
    if (!S.next(0, cur)) return;
    f32x4 acc[2][2][4][2];
#pragma unroll
    for (int a = 0; a < 2; ++a)
#pragma unroll
        for (int b = 0; b < 2; ++b)
#pragma unroll
            for (int m = 0; m < 4; ++m)
#pragma unroll
                for (int n = 0; n < 2; ++n) acc[a][b][m][n] = (f32x4){0.f, 0.f, 0.f, 0.f};
    bf16x8 At[4][2], B0[2][2], B1[2][2];
    const char* cA = rfl_ptr(cur.aB); const char* cB = rfl_ptr(cur.bB);
    GP_AOFF(ac, cur);
    GP_STAGE(GP_SB(0, 0), cB, voffB[0], voffB[1]); GP_STAGE(GP_SB(0, 1), cB + hstepB, voffB[0], voffB[1]); { constexpr bool last = false; GP_STAGE_A(GP_SA(0, 0), cA, 0, 0); GP_STAGE_A(GP_SA(0, 1), cA, 1, 0); }
    if (wr == 1) GP_BAR;
    GP_WAIT_V(2); GP_BAR;
    GP_STAGE(GP_SB(1, 0), cB + kstep, voffB[0], voffB[1]); { constexpr bool last = false; GP_STAGE_A(GP_SA(1, 0), cA + kstep, 0, 0); } GP_STAGE(GP_SB(1, 1), cB + hstepB + kstep, voffB[0], voffB[1]);
    GP_WAIT_V(6); GP_BAR;
    for (;;) {
        const bool has_next = S.next(ui + 1, nxt);
        const char* nA = has_next ? rfl_ptr(nxt.aB) : cA; const char* nB = has_next ? rfl_ptr(nxt.bB) : cB;
        if constexpr (Sched::GATHER) { if (has_next) { GP_AOFF(an, nxt); } else {
            an[0] = ac[0]; an[1] = ac[1]; } }
        const int nt = cur.nt;
        int pre8[8];
        if constexpr (Epi::PRE) { unsigned m4 = ~0u; asm volatile("" : "+s"(m4)); const int l4 = (int)__builtin_amdgcn_mbcnt_hi(m4, __builtin_amdgcn_mbcnt_lo(m4, 0u)); E.prefetch(cur, wr, l4 & 15, pre8); }
        const bool hi = !(Sched::SKIPHI && cur.aux <= 128);
        for (int t = 0; t < nt; t += 2) {
            const bool last = (t == nt - 2);
            const char* a1 = cA + (size_t)(t + 1) * kstep;
            const char* a2 = last ? nA : cA + (size_t)(t + 2) * kstep; const char* b2 = last ? nB : cB + (size_t)(t + 2) * kstep;
            const char* a3 = a2 + kstep; const char* b3 = b2 + kstep;
            GP_LDB(B0, 0, 0); GP_LDB(B1, 0, 1); GP_SCHED; GP_LDA(At, 0, 0); GP_STAGE_A(GP_SA(1, 1), a1, 1, 0);
            GP_WAIT_V(8); GP_WAIT_L(0); GP_BAR; GP_MMA(0, 0, At, B0); GP_MMA(0, 1, At, B1); GP_BAR; GP_SCHED;
            if (hi) GP_LDA(At, 0, 1); GP_STAGE(GP_SB(0, 0), b2, voffB[0], voffB[1]); GP_STAGE(GP_SB(0, 1), b2 + hstepB, voffB[0], voffB[1]); GP_STAGE_A(GP_SA(0, 0), a2, 0, 1);
            GP_WAIT_V(8); GP_WAIT_L(0); GP_BAR; if (hi) { GP_MMA(1, 0, At, B0); GP_MMA(1, 1, At, B1); } GP_BAR; GP_SCHED;
            GP_LDB(B0, 1, 0); GP_LDB(B1, 1, 1); GP_SCHED; GP_LDA(At, 1, 0); GP_STAGE_A(GP_SA(0, 1), a2, 1, 1);
            GP_WAIT_V(8); GP_WAIT_L(0); GP_BAR; GP_MMA(0, 0, At, B0); GP_MMA(0, 1, At, B1); GP_BAR; GP_SCHED;
            if (hi) GP_LDA(At, 1, 1); GP_STAGE(GP_SB(1, 0), b3, voffB[0], voffB[1]); GP_STAGE(GP_SB(1, 1), b3 + hstepB, voffB[0], voffB[1]); GP_STAGE_A(GP_SA(1, 0), a3, 0, 1);
            GP_WAIT_V(8); GP_WAIT_L(0); GP_BAR; if (hi) { GP_MMA(1, 0, At, B0); GP_MMA(1, 1, At, B1); } GP_BAR; GP_SCHED;
        }
        if (wr == 0) GP_BAR;
        { unsigned m2 = ~0u; asm volatile("" : "+s"(m2)); const int l2 = (int)__builtin_amdgcn_mbcnt_hi(m2, __builtin_amdgcn_mbcnt_lo(m2, 0u));
          if constexpr (Epi::PRE) E(acc, cur, wr, wc, l2 & 15, l2 >> 4, pre8); else E(acc, cur, wr, wc, l2 & 15, l2 >> 4); }
        if constexpr (Sched::HOOKS) S.done(cur);
        if (!has_next) break;
#pragma unroll
        for (int a = 0; a < 2; ++a)
#pragma unroll
            for (int b = 0; b < 2; ++b)
#pragma unroll
                for (int m = 0; m < 4; ++m)
#pragma unroll
                    for (int n = 0; n < 2; ++n) acc[a][b][m][n] = (f32x4){0.f, 0.f, 0.f, 0.f};
        cur = nxt; cA = nA; cB = nB; ++ui;
        if constexpr (Sched::GATHER) { ac[0] = an[0]; ac[1] = an[1]; }
        if (wr == 1) GP_BAR;
    }
    GP_WAIT_V(0);
    GP_BAR;
#undef GP_AOFF
#undef GP_STAGE_A
#undef GP_SA
#undef GP_SB
#undef GP_STAGE
#undef GP_LDA
#undef GP_LDB
#undef GP_MMA
#undef GP_WAIT_V
#undef GP_WAIT_L
#undef GP_BAR
#undef GP_SCHED
}
}
namespace sb {
typedef short bf16x8 __attribute__((ext_vector_type(8)));
typedef short s16x4 __attribute__((ext_vector_type(4)));
typedef float f32x16 __attribute__((ext_vector_type(16)));
typedef unsigned u32x4 __attribute__((ext_vector_type(4)));
typedef unsigned u32x2 __attribute__((ext_vector_type(2)));
constexpr int VS = 192;
constexpr int VT_BYTES = 64 * VS;
#define SB_MFMA(a, b, c) __builtin_amdgcn_mfma_f32_32x32x16_bf16((a), (b), (c), 0, 0, 0)

__device__ __forceinline__ unsigned cvt2(float lo, float hi) { typedef float f2_ __attribute__((ext_vector_type(2))); typedef __bf16 b2_ __attribute__((ext_vector_type(2))); const f2_ v_ = {lo, hi}; return __builtin_bit_cast(unsigned, __builtin_convertvector(v_, b2_)); }
__device__ __forceinline__ bf16x8 pack_step(const float (&x)[16], int s) {
    u32x4 p; p[0] = cvt2(x[8 * s], x[8 * s + 1]); p[1] = cvt2(x[8 * s + 2], x[8 * s + 3]); p[2] = cvt2(x[8 * s + 4], x[8 * s + 5]); p[3] = cvt2(x[8 * s + 6], x[8 * s + 7]);
    return __builtin_bit_cast(bf16x8, p);
}
__device__ __forceinline__ void tr_read4(s16x4& r0, s16x4& r1, s16x4& r2, s16x4& r3, unsigned a0, unsigned a1, unsigned a2, unsigned a3) {
    asm volatile("ds_read_b64_tr_b16 %0, %4\n\tds_read_b64_tr_b16 %1, %5\n\tds_read_b64_tr_b16 %2, %6\n\tds_read_b64_tr_b16 %3, %7\n\ts_waitcnt lgkmcnt(0)"
                 : "=&v"(r0), "=&v"(r1), "=&v"(r2), "=&v"(r3) : "v"(a0), "v"(a1), "v"(a2), "v"(a3) : "memory");
}
__device__ __forceinline__ float partner32(float x, int hh) {
    const auto r = __builtin_amdgcn_permlane32_swap(__float_as_uint(x), __float_as_uint(x), false, false);
    return __uint_as_float(hh ? r[0] : r[1]);
}

template <bool MASK, int NKB>
__device__ __forceinline__ void sb_tile(const unsigned short* PROJ, const size_t krow0, const int h, const int r, const int hh, const int vrow, const int vchunk, LAS unsigned char* vtp, const unsigned tra,
                                        const bf16x8 (&qf)[4], float (&o0)[16], float (&o1)[16], float& carry, const int tq) {
    constexpr int LDP = 2816, CK = 1552, CV = 1936;
    u32x4 vreg[4 * NKB];
#pragma unroll
    for (int i = 0; i < 4 * NKB; ++i) vreg[i] = *(const u32x4*)(PROJ + (krow0 + 8 * i + vrow) * LDP + CV + h * 64 + 8 * vchunk);
    float sv[NKB][16];
    { const unsigned short* kp = PROJ + (krow0 + r) * LDP + CK + h * 64 + 8 * hh;
      bf16x8 kf[NKB][4];
#pragma unroll
      for (int kb = 0; kb < NKB; ++kb)
#pragma unroll
          for (int ks = 0; ks < 4; ++ks) kf[kb][ks] = *(const bf16x8*)(kp + (size_t)32 * kb * LDP + 16 * ks);
#pragma unroll
      for (int kb = 0; kb < NKB; ++kb) { f32x16 s;
#pragma unroll
          for (int i = 0; i < 16; ++i) s[i] = 0.f;
#pragma unroll
          for (int ks = 0; ks < 4; ++ks) s = SB_MFMA(kf[kb][ks], qf[ks], s);
#pragma unroll
          for (int i = 0; i < 16; ++i) sv[kb][i] = s[i]; } }
#pragma unroll
    for (int i = 0; i < 4 * NKB; ++i) *(LAS u32x4*)(vtp + (8 * i + vrow) * VS + 16 * vchunk) = vreg[i];
    float L[NKB][16], M[NKB][16];
#pragma unroll
    for (int kb = 0; kb < NKB; ++kb)
#pragma unroll
        for (int i = 0; i < 16; ++i) { const float z = sv[kb][i];
            const float e = __builtin_amdgcn_exp2f(-__builtin_fabsf(z)); const float lg = __builtin_amdgcn_logf(1.0f + e);
            M[kb][i] = fminf(z, 0.f) - lg; L[kb][i] = M[kb][i] - z;
            if constexpr (MASK) { const int kk = 32 * kb + (i & 3) + 8 * (i >> 2) + 4 * hh; L[kb][i] = (kk < tq) ? L[kb][i] : 0.f; } }
    float G[NKB][4], Gp[NKB][4];
#pragma unroll
    for (int kb = 0; kb < NKB; ++kb)
#pragma unroll
        for (int u = 0; u < 4; ++u) { G[kb][u] = (L[kb][4 * u] + L[kb][4 * u + 1]) + (L[kb][4 * u + 2] + L[kb][4 * u + 3]); Gp[kb][u] = partner32(G[kb][u], hh); }
    float run = carry; float A[NKB][16];
#pragma unroll
    for (int kb = NKB - 1; kb >= 0; --kb)
#pragma unroll
        for (int u = 3; u >= 0; --u) {
            const float off = run + (hh ? 0.f : Gp[kb][u]);
            run += G[kb][u] + Gp[kb][u];
            const float l3 = L[kb][4 * u + 3], l2 = L[kb][4 * u + 2], l1 = L[kb][4 * u + 1];
            const float sf3 = off, sf2 = off + l3, sf1 = sf2 + l2, sf0 = sf1 + l1;
            A[kb][4 * u + 3] = __builtin_amdgcn_exp2f(M[kb][4 * u + 3] + sf3); A[kb][4 * u + 2] = __builtin_amdgcn_exp2f(M[kb][4 * u + 2] + sf2);
            A[kb][4 * u + 1] = __builtin_amdgcn_exp2f(M[kb][4 * u + 1] + sf1); A[kb][4 * u + 0] = __builtin_amdgcn_exp2f(M[kb][4 * u + 0] + sf0);
            if constexpr (MASK) { const int kk0 = 32 * kb + 8 * u + 4 * hh;
                A[kb][4 * u + 3] = (kk0 + 3 < tq) ? A[kb][4 * u + 3] : 0.f; A[kb][4 * u + 2] = (kk0 + 2 < tq) ? A[kb][4 * u + 2] : 0.f;
                A[kb][4 * u + 1] = (kk0 + 1 < tq) ? A[kb][4 * u + 1] : 0.f; A[kb][4 * u + 0] = (kk0 + 0 < tq) ? A[kb][4 * u + 0] : 0.f; }
        }
    carry = run;
    asm volatile("s_waitcnt lgkmcnt(0)" ::: "memory");
#pragma unroll
    for (int kb = 0; kb < NKB; ++kb)
#pragma unroll
        for (int s = 0; s < 2; ++s) {
            const bf16x8 pb = pack_step(A[kb], s);
            const unsigned a_lo = tra + (unsigned)((32 * kb + 16 * s + 4 * hh) * VS), a_hi = a_lo + 8 * VS;
            s16x4 l0, h0, l1, h1;
            tr_read4(l0, h0, l1, h1, a_lo, a_hi, a_lo + 64, a_hi + 64);
            const bf16x8 va0 = __builtin_shufflevector(l0, h0, 0, 1, 2, 3, 4, 5, 6, 7), va1 = __builtin_shufflevector(l1, h1, 0, 1, 2, 3, 4, 5, 6, 7);
            f32x16 t0, t1;
#pragma unroll
            for (int i = 0; i < 16; ++i) { t0[i] = o0[i]; t1[i] = o1[i]; }
            t0 = SB_MFMA(va0, pb, t0); t1 = SB_MFMA(va1, pb, t1);
#pragma unroll
            for (int i = 0; i < 16; ++i) { o0[i] = t0[i]; o1[i] = t1[i]; }
        }
}

__device__ __forceinline__ void sb_phase(LAS unsigned char* lds, const unsigned short* PROJ, unsigned short* MIX, const int vcu, const int G, const int wave, const int lane) {
    constexpr int LDP = 2816, CQ = 1168, CK = 1552, CV = 1936, S = 4096;
    const int r = lane & 31, hh = lane >> 5;
    const unsigned vt = (unsigned)(wave * VT_BYTES);
    LAS unsigned char* vtp = lds + wave * VT_BYTES;
    const unsigned tra = vt + (unsigned)(((lane & 15) >> 2) * VS + (((lane >> 4) & 1) * 16 + (lane & 3) * 4) * 2);
    const int vrow = lane >> 3, vchunk = lane & 7;
    const int ipc = (3072 + G - 1) / G;
    for (int li = wave; li < ipc; li += 8) {
        const int wi = vcu * ipc + li; if (wi >= 3072) break;
        const int w4 = wi & 3, qb = (wi >> 2) & 31, bh = wi >> 7, h = bh % 6, b = bh / 6;
        const int q0 = qb * 128 + w4 * 32;
        const size_t rowbase = (size_t)b * S;
        bf16x8 qf[4];
        {
            const unsigned short* qp = PROJ + (rowbase + q0 + r) * LDP + CQ + h * 64 + 8 * hh;
#pragma unroll
            for (int ks = 0; ks < 4; ++ks) { const u32x4 raw = *(const u32x4*)(qp + 16 * ks); u32x4 o;
#pragma unroll
                for (int e = 0; e < 4; ++e) { const float lo = __uint_as_float(raw[e] << 16) * 0.18033688f, hi = __uint_as_float(raw[e] & 0xffff0000u) * 0.18033688f;
                    o[e] = cvt2(lo, hi); }
                qf[ks] = __builtin_bit_cast(bf16x8, o); }
        }
        float o0[16], o1[16];
#pragma unroll
        for (int i = 0; i < 16; ++i) { o0[i] = 0.f; o1[i] = 0.f; }
        float carry = 0.f;
        const int trel0 = q0 + r;
        {
            const int j0 = q0 >> 6; const size_t krow0 = rowbase + (size_t)j0 * 64; const int tq = trel0 - j0 * 64;
            if ((q0 & 63) == 0) sb_tile<true, 1>(PROJ, krow0, h, r, hh, vrow, vchunk, vtp, tra, qf, o0, o1, carry, tq);
            else sb_tile<true, 2>(PROJ, krow0, h, r, hh, vrow, vchunk, vtp, tra, qf, o0, o1, carry, tq);
            for (int j = j0 - 1; j >= 0; --j) {
                if (__builtin_amdgcn_ballot_w64(carry > -135.0f) == 0ull) break;
                sb_tile<false, 2>(PROJ, rowbase + (size_t)j * 64, h, r, hh, vrow, vchunk, vtp, tra, qf, o0, o1, carry, 64);
            }
        }
        unsigned short* op = MIX + (rowbase + q0 + r) * 1024 + 384 + h * 64 + 4 * hh;
#pragma unroll
        for (int u = 0; u < 4; ++u) {
            u32x2 w0, w1;
            w0.x = cvt2(o0[4 * u], o0[4 * u + 1]); w0.y = cvt2(o0[4 * u + 2], o0[4 * u + 3]);
            w1.x = cvt2(o1[4 * u], o1[4 * u + 1]); w1.y = cvt2(o1[4 * u + 2], o1[4 * u + 3]);
            *(u32x2*)(op + 8 * u) = w0; *(u32x2*)(op + 32 + 8 * u) = w1;
        }
    }
}
#undef SB_MFMA
}
namespace gla {
typedef short bf16x8 __attribute__((ext_vector_type(8)));
typedef short s16x4 __attribute__((ext_vector_type(4)));
typedef float f32x4 __attribute__((ext_vector_type(4)));
typedef float f32x16 __attribute__((ext_vector_type(16)));
typedef unsigned u32x4 __attribute__((ext_vector_type(4)));
typedef unsigned u32x2 __attribute__((ext_vector_type(2)));
constexpr int LDP = 2816, C_GQ = 0, C_GK = 192, C_GV = 384, C_GO = 768, C_LR = 1152, C_PU = 2320;
constexpr int VSG = 784;
constexpr int KOS = 400;
constexpr int PLS = 528;
constexpr int L_Q = 0, L_U = L_Q + 64 * KOS, L_KI = L_U, L_V = 0, L_KO = L_U + 80 * PLS, L_PL = L_KO + 64 * KOS, L_LR = L_PL + 64 * PLS, L_TOT = L_LR + 64 * 16 * 4, L_BL = L_TOT + 768, L_END = L_BL + 768;
static_assert(64 * VSG <= L_KO && L_END <= 147456, "gla LDS map");
__device__ __forceinline__ float bflo(unsigned u) { return __uint_as_float(u << 16); }
__device__ __forceinline__ float bfhi(unsigned u) { return __uint_as_float(u & 0xffff0000u); }
__device__ __forceinline__ float bf1(unsigned short u) { return __uint_as_float((unsigned)u << 16); }
__device__ __forceinline__ unsigned short f2bf1(float f) { unsigned u = __float_as_uint(f); return (unsigned short)((u + 0x7fffu + ((u >> 16) & 1u)) >> 16); }
__device__ __forceinline__ unsigned cvtpk(float lo, float hi) { typedef float f2_ __attribute__((ext_vector_type(2))); typedef __bf16 b2_ __attribute__((ext_vector_type(2))); const f2_ v_ = {lo, hi}; return __builtin_bit_cast(unsigned, __builtin_convertvector(v_, b2_)); }
__device__ __forceinline__ void tr_read2(s16x4& r0, s16x4& r1, unsigned a0, unsigned a1) {
    asm volatile("ds_read_b64_tr_b16 %0, %2\n\tds_read_b64_tr_b16 %1, %3\n\ts_waitcnt lgkmcnt(0)" : "=&v"(r0), "=&v"(r1) : "v"(a0), "v"(a1) : "memory");
}
__device__ __forceinline__ bf16x8 pack_step(const float (&x)[16], int s) {
    u32x4 p; p[0] = cvtpk(x[8 * s], x[8 * s + 1]); p[1] = cvtpk(x[8 * s + 2], x[8 * s + 3]); p[2] = cvtpk(x[8 * s + 4], x[8 * s + 5]); p[3] = cvtpk(x[8 * s + 6], x[8 * s + 7]);
    return __builtin_bit_cast(bf16x8, p);
}
__device__ __forceinline__ float partner32(float x, int hh) { const auto r = __builtin_amdgcn_permlane32_swap(__float_as_uint(x), __float_as_uint(x), false, false); return __uint_as_float(hh ? r[0] : r[1]); }
__device__ __forceinline__ float logsig(float x) { return fminf(x, 0.f) - __logf(1.0f + __expf(-fabsf(x))); }

__device__ __forceinline__ void stage_v(LAS unsigned char* lds, const unsigned short* PROJ, size_t t0, int tid) {
#pragma unroll
    for (int i = 0; i < 6; ++i) { const int idx = tid + 512 * i, row = idx / 48, ch = idx % 48;
        *(LAS u32x4*)(lds + L_V + row * VSG + 16 * ch) = *(const u32x4*)(PROJ + (t0 + row) * LDP + C_GV + 8 * ch); }
}

struct G1Args { const unsigned short* PROJ; const float* w_lr2; const float* b_lr; unsigned short* QD; unsigned short* KI; float* KVT; float* DEC; const unsigned short* WPLT; const float* pool_scale; unsigned short* MIX; };
template <bool POOL> __device__ __forceinline__ void gla1_phase(LAS unsigned char* lds, const G1Args& a, const int vcu, const int G, const int wave, const int lane_, const int tid_) {
    for (int ch = vcu; ch < 256; ch += G) {
        int lane = lane_; asm volatile("" : "+v"(lane)); const int tid = wave * 64 + lane; (void)tid_;
        const size_t t0 = (size_t)ch * 64; const int tpos0 = (ch & 63) * 64;
        __syncthreads();
        u32x4 vreg[6];
#pragma unroll
        for (int i = 0; i < 6; ++i) { const int idx = tid + 512 * i, row = idx / 48, c8 = idx % 48; vreg[i] = *(const u32x4*)(a.PROJ + (t0 + row) * LDP + C_GV + 8 * c8); }
#pragma unroll
        for (int i = 0; i < 3; ++i) { const int idx = tid + 512 * i, row = idx / 24, c8 = idx % 24;
            *(LAS u32x4*)(lds + L_Q + row * KOS + 16 * c8) = *(const u32x4*)(a.PROJ + (t0 + row) * LDP + C_GQ + 8 * c8);
            *(LAS u32x4*)(lds + L_KO + row * KOS + 16 * c8) = *(const u32x4*)(a.PROJ + (t0 + row) * LDP + C_GK + 8 * c8); }
        if constexpr (POOL)
#pragma unroll
        for (int i = 0; i < 5; ++i) { const int idx = tid + 512 * i, row = idx / 32, c8 = idx % 32;
            u32x4 v = (u32x4){0u, 0u, 0u, 0u}; if (tpos0 - 16 + row >= 0) v = *(const u32x4*)(a.PROJ + (t0 + row - 16) * LDP + C_PU + 8 * c8);
            *(LAS u32x4*)(lds + L_U + row * PLS + 16 * c8) = v; }
        if (tid < 128) { const int row = tid >> 1, half = tid & 1; const u32x4 raw = *(const u32x4*)(a.PROJ + (t0 + row) * LDP + C_LR + 8 * half);
            LAS float* dst = (LAS float*)(lds + L_LR) + row * 16 + 8 * half;
            dst[0] = bflo(raw.x); dst[1] = bfhi(raw.x); dst[2] = bflo(raw.y); dst[3] = bfhi(raw.y); dst[4] = bflo(raw.z); dst[5] = bfhi(raw.z); dst[6] = bflo(raw.w); dst[7] = bfhi(raw.w); }
        const int c = POOL ? tid % 192 : ((tid < 384) ? 32 * (tid >> 6) + (tid & 31) : 0), hf = POOL ? tid / 192 : ((tid >> 5) & 1); float w[16]; float bias = 0.f;
        if (tid < 384) {
#pragma unroll
            for (int r = 0; r < 16; ++r) w[r] = a.w_lr2[r * 192 + c];
            bias = a.b_lr[c]; }
        __syncthreads();
        if constexpr (POOL) { const int j = tid & 255, ph = tid >> 8, gi = j >> 6, w = 2 << gi; const LAS unsigned char* up = lds + L_U + 2 * j + (16 + 32 * ph) * PLS;
          const int tp0 = tpos0 + 32 * ph;
          float ws = 0.f;
          for (int i = 1; i <= w; ++i) ws += bf1(*(const LAS unsigned short*)(up - i * PLS));
          LAS unsigned char* pp = lds + L_PL + 32 * ph * PLS + 2 * j;
#pragma unroll 8
          for (int i = 0; i < 32; ++i) { const float u = bf1(*(const LAS unsigned short*)(up + i * PLS));
              ws += u - bf1(*(const LAS unsigned short*)(up + (i - w) * PLS));
              const int tp = tp0 + i; const int cnt = (tp + 1 < w) ? tp + 1 : w;
              *(LAS unsigned short*)(pp + i * PLS) = f2bf1(ws * __builtin_amdgcn_rcpf((float)cnt) - u); } }
        float val[32];
        if (tid < 384) {
            const LAS f32x4* lr = (const LAS f32x4*)(lds + L_LR) + 32 * hf * 4;
#pragma unroll
            for (int i = 0; i < 32; ++i) { float s = bias;
#pragma unroll
                for (int q = 0; q < 4; ++q) { const f32x4 x = lr[4 * i + q]; s += x.x * w[4 * q] + x.y * w[4 * q + 1] + x.z * w[4 * q + 2] + x.w * w[4 * q + 3]; }
                val[i] = logsig(s) * 0.0625f; }
#pragma unroll
            for (int i = 1; i < 32; ++i) val[i] += val[i - 1];
            if constexpr (POOL) { if (hf == 0) ((LAS float*)(lds + L_TOT))[c] = val[31]; }
        }
        float blr = 0.f;
        if constexpr (POOL) {
        __syncthreads();
        if (tid < 384 && hf == 1) { const float t = ((LAS float*)(lds + L_TOT))[c];
#pragma unroll
            for (int i = 0; i < 32; ++i) val[i] += t;
            ((LAS float*)(lds + L_BL))[c] = val[31]; a.DEC[(size_t)ch * 192 + c] = __expf(val[31]); }
        __syncthreads();
        } else if (tid < 384) {
            const float tot = val[31], ptot = partner32(tot, hf);
            if (hf == 1) {
#pragma unroll
                for (int i = 0; i < 32; ++i) val[i] += ptot;
                a.DEC[(size_t)ch * 192 + c] = __expf(val[31]); }
            blr = (hf == 1) ? val[31] : tot + ptot;
        }
        if (tid < 384) { const float bl = POOL ? ((LAS float*)(lds + L_BL))[c] : blr;
            LAS unsigned char* qp = lds + L_Q + 32 * hf * KOS + 2 * c; LAS unsigned char* kp = lds + L_KO + 32 * hf * KOS + 2 * c; LAS unsigned char* ip = lds + L_KI + 32 * hf * KOS + 2 * c;
#pragma unroll
            for (int i = 0; i < 32; ++i) { const float b = val[i];
                const float q = bf1(*(const LAS unsigned short*)(qp + i * KOS)), k = bf1(*(const LAS unsigned short*)(kp + i * KOS));
                *(LAS unsigned short*)(qp + i * KOS) = f2bf1(q * 0.14433756729740643f * __expf(b)); *(LAS unsigned short*)(ip + i * KOS) = f2bf1(k * __expf(-b));
                *(LAS unsigned short*)(kp + i * KOS) = f2bf1(k * __expf(bl - b)); } }
        __syncthreads();
#pragma unroll
        for (int i = 0; i < 3; ++i) { const int idx = tid + 512 * i, row = idx / 24, c8 = idx % 24;
            *(u32x4*)(a.QD + (t0 + row) * 192 + 8 * c8) = *(const LAS u32x4*)(lds + L_Q + row * KOS + 16 * c8);
            *(u32x4*)(a.KI + (t0 + row) * 192 + 8 * c8) = *(const LAS u32x4*)(lds + L_KI + row * KOS + 16 * c8); }
        __syncthreads();
#pragma unroll
        for (int i = 0; i < 6; ++i) { const int idx = tid + 512 * i, row = idx / 48, c8 = idx % 48; *(LAS u32x4*)(lds + L_V + row * VSG + 16 * c8) = vreg[i]; }
        __syncthreads();
        bf16x8 wpl[2][4]; f32x4 psc[4];
        if constexpr (POOL) { const int gi = wave >> 1, g4 = lane >> 4, lr = lane & 15;
#pragma unroll
          for (int ks = 0; ks < 2; ++ks)
#pragma unroll
              for (int m = 0; m < 4; ++m) wpl[ks][m] = *(const bf16x8*)(a.WPLT + ((size_t)gi * 64 + 16 * m + lr) * 64 + 32 * ks + 8 * g4);
#pragma unroll
          for (int m = 0; m < 4; ++m) psc[m] = *(const f32x4*)(a.pool_scale + gi * 64 + 16 * m + 4 * g4); }
        { const int h = wave >> 1, half = wave & 1, g4 = lane >> 4, q = (lane & 15) >> 2, p = lane & 3;
          f32x4 acc[3][3];
#pragma unroll
          for (int m = 0; m < 3; ++m)
#pragma unroll
              for (int n = 0; n < 3; ++n) acc[m][n] = (f32x4){0.f, 0.f, 0.f, 0.f};
#pragma unroll
          for (int ks = 0; ks < 2; ++ks) {
              const int tokr = 32 * ks + 8 * g4 + q;
              bf16x8 bf[3];
#pragma unroll
              for (int n = 0; n < 3; ++n) { s16x4 lo, hi; const unsigned ad = (unsigned)(L_KO + tokr * KOS + (h * 48 + 16 * n + 4 * p) * 2); tr_read2(lo, hi, ad, ad + 4 * KOS);
                  bf[n] = __builtin_shufflevector(lo, hi, 0, 1, 2, 3, 4, 5, 6, 7); }
#pragma unroll
              for (int m = 0; m < 3; ++m) { s16x4 lo, hi; const unsigned ad = (unsigned)(L_V + tokr * VSG + (h * 96 + 16 * (3 * half + m) + 4 * p) * 2); tr_read2(lo, hi, ad, ad + 4 * VSG);
                  const bf16x8 af = __builtin_shufflevector(lo, hi, 0, 1, 2, 3, 4, 5, 6, 7);
#pragma unroll
                  for (int n = 0; n < 3; ++n) acc[m][n] = __builtin_amdgcn_mfma_f32_16x16x32_bf16(af, bf[n], acc[m][n], 0, 0, 0); }
          }
          unsigned short* kv = (unsigned short*)a.KVT + ((size_t)ch * 4 + h) * 96 * 48;
#pragma unroll
          for (int m = 0; m < 3; ++m)
#pragma unroll
              for (int n = 0; n < 3; ++n)
#pragma unroll
                  for (int jj = 0; jj < 4; ++jj) kv[(16 * (3 * half + m) + 4 * g4 + jj) * 48 + 16 * n + (lane & 15)] = f2bf1(acc[m][n][jj]);
        }
        if constexpr (POOL) { const int gi = wave >> 1, half = wave & 1, g4 = lane >> 4, lr = lane & 15;
          f32x4 acc[4][2];
#pragma unroll
          for (int m = 0; m < 4; ++m) { acc[m][0] = (f32x4){0.f, 0.f, 0.f, 0.f}; acc[m][1] = (f32x4){0.f, 0.f, 0.f, 0.f}; }
#pragma unroll
          for (int ks = 0; ks < 2; ++ks) {
              bf16x8 bf[2];
#pragma unroll
              for (int n = 0; n < 2; ++n) bf[n] = *(const LAS bf16x8*)(lds + L_PL + (16 * (2 * half + n) + lr) * PLS + (gi * 64 + 32 * ks + 8 * g4) * 2);
#pragma unroll
              for (int m = 0; m < 4; ++m) { const bf16x8 af = wpl[ks][m];
                  acc[m][0] = __builtin_amdgcn_mfma_f32_16x16x32_bf16(af, bf[0], acc[m][0], 0, 0, 0); acc[m][1] = __builtin_amdgcn_mfma_f32_16x16x32_bf16(af, bf[1], acc[m][1], 0, 0, 0); }
          }
#pragma unroll
          for (int m = 0; m < 4; ++m) { const int d0 = gi * 64 + 16 * m + 4 * g4; const f32x4 sc = psc[m];
#pragma unroll
              for (int n = 0; n < 2; ++n) { const size_t row = t0 + 16 * (2 * half + n) + lr; u32x2 o; o.x = cvtpk(acc[m][n][0] * sc.x, acc[m][n][1] * sc.y); o.y = cvtpk(acc[m][n][2] * sc.z, acc[m][n][3] * sc.w);
                  *(u32x2*)(a.MIX + row * 1024 + 768 + d0) = o; } }
        }
    }
}

constexpr int UST = 144;
__device__ __forceinline__ void pool_wave(LAS unsigned char* ubuf, LAS unsigned char* pbuf, const unsigned short* PROJ, const unsigned short* WPLT, const float* pool_scale, unsigned short* MIX, const int ch, const int gi, const int lane) {
    const size_t t0 = (size_t)ch * 64; const int tpos0 = (ch & 63) * 64; const int g4 = lane >> 4, lr = lane & 15;
    u32x4 uv[10];
#pragma unroll
    for (int i = 0; i < 10; ++i) { const int idx = lane + 64 * i, row = idx >> 3, c8 = idx & 7; uv[i] = (u32x4){0u, 0u, 0u, 0u};
        if (tpos0 - 16 + row >= 0) uv[i] = *(const u32x4*)(PROJ + (t0 + row - 16) * LDP + C_PU + gi * 64 + 8 * c8); }
    bf16x8 wpl[2][4]; f32x4 psc[4];
#pragma unroll
    for (int ks = 0; ks < 2; ++ks)
#pragma unroll
        for (int m = 0; m < 4; ++m) wpl[ks][m] = *(const bf16x8*)(WPLT + ((size_t)gi * 64 + 16 * m + lr) * 64 + 32 * ks + 8 * g4);
#pragma unroll
    for (int m = 0; m < 4; ++m) psc[m] = *(const f32x4*)(pool_scale + gi * 64 + 16 * m + 4 * g4);
#pragma unroll
    for (int i = 0; i < 10; ++i) { const int idx = lane + 64 * i, row = idx >> 3, c8 = idx & 7; *(LAS u32x4*)(ubuf + row * UST + 16 * c8) = uv[i]; }
    { const int w = 2 << gi; const LAS unsigned char* up = ubuf + 2 * lane + 16 * UST; LAS unsigned char* pp = pbuf + 2 * lane;
      float ws = 0.f;
      for (int i = 1; i <= w; ++i) ws += bf1(*(const LAS unsigned short*)(up - i * UST));
#pragma unroll 8
      for (int i = 0; i < 64; ++i) { const float u = bf1(*(const LAS unsigned short*)(up + i * UST));
          ws += u - bf1(*(const LAS unsigned short*)(up + (i - w) * UST));
          const int tp = tpos0 + i; const int cnt = (tp + 1 < w) ? tp + 1 : w;
          *(LAS unsigned short*)(pp + i * UST) = f2bf1(ws * __builtin_amdgcn_rcpf((float)cnt) - u); } }
#pragma unroll
    for (int half = 0; half < 2; ++half) {
        f32x4 acc[4][2];
#pragma unroll
        for (int m = 0; m < 4; ++m) { acc[m][0] = (f32x4){0.f, 0.f, 0.f, 0.f}; acc[m][1] = (f32x4){0.f, 0.f, 0.f, 0.f}; }
#pragma unroll
        for (int ks = 0; ks < 2; ++ks) { bf16x8 bf[2];
#pragma unroll
            for (int n = 0; n < 2; ++n) bf[n] = *(const LAS bf16x8*)(pbuf + (16 * (2 * half + n) + lr) * UST + (32 * ks + 8 * g4) * 2);
#pragma unroll
            for (int m = 0; m < 4; ++m) { acc[m][0] = __builtin_amdgcn_mfma_f32_16x16x32_bf16(wpl[ks][m], bf[0], acc[m][0], 0, 0, 0); acc[m][1] = __builtin_amdgcn_mfma_f32_16x16x32_bf16(wpl[ks][m], bf[1], acc[m][1], 0, 0, 0); } }
#pragma unroll
        for (int m = 0; m < 4; ++m) { const int d0 = gi * 64 + 16 * m + 4 * g4; const f32x4 sc = psc[m];
#pragma unroll
            for (int n = 0; n < 2; ++n) { const size_t row = t0 + 16 * (2 * half + n) + lr; u32x2 o; o.x = cvtpk(acc[m][n][0] * sc.x, acc[m][n][1] * sc.y); o.y = cvtpk(acc[m][n][2] * sc.z, acc[m][n][3] * sc.w);
                *(u32x2*)(MIX + row * 1024 + 768 + d0) = o; } }
    }
}

__device__ __forceinline__ void gla2_phase(const float* KVT, const float* DEC, unsigned short* STB, const int gtid, const int GT) {
    for (int e = gtid; e < 4 * 4 * 96 * 48; e += GT) {
        const int d = e % 48; int r = e / 48; const int v = r % 96; r /= 96; const int h = r & 3, b = r >> 2;
        float st = 0.f;
#pragma unroll 16
        for (int n = 0; n < 64; ++n) { const size_t chn = (size_t)b * 64 + n; const size_t idx = ((chn * 4 + h) * 96 + v) * 48 + d;
            STB[idx] = f2bf1(st); st = DEC[chn * 192 + h * 48 + d] * st + bf1(((const unsigned short*)KVT)[idx]); }
    }
}

struct G3Args { const unsigned short* PROJ; const unsigned short* QD; const unsigned short* KI; const unsigned short* STB; const float* norm_g; unsigned short* MIX; };
struct G3Pre { bf16x8 qd[3]; float att[2][16]; u32x2 gog[3][4]; };
__device__ __forceinline__ void gla3_pre(LAS unsigned char* lds, const G3Args& a, const int ch, const int wave, const int lane, const int tid, G3Pre& P) {
    const int r = lane & 31, hh = lane >> 5, h = wave >> 1, c0 = 32 * (wave & 1);
    {
        const size_t t0 = (size_t)ch * 64;
        __syncthreads();
        stage_v(lds, a.PROJ, t0, tid);

#pragma unroll
        for (int ks = 0; ks < 3; ++ks) P.qd[ks] = *(const bf16x8*)(a.QD + (t0 + c0 + r) * 192 + h * 48 + 16 * ks + 8 * hh);


#pragma unroll
        for (int sb = 0; sb < 2; ++sb) { f32x16 t;
#pragma unroll
            for (int i = 0; i < 16; ++i) t[i] = 0.f;
#pragma unroll
            for (int ks = 0; ks < 3; ++ks) { const bf16x8 kf = *(const bf16x8*)(a.KI + (t0 + 32 * sb + r) * 192 + h * 48 + 16 * ks + 8 * hh); t = __builtin_amdgcn_mfma_f32_32x32x16_bf16(kf, P.qd[ks], t, 0, 0, 0); }
#pragma unroll
            for (int i = 0; i < 16; ++i) { const int s = 32 * sb + (i & 3) + 8 * (i >> 2) + 4 * hh; P.att[sb][i] = (s <= c0 + r) ? t[i] : 0.f; } }
        unsigned zd = __float_as_uint(P.att[1][15]); asm volatile("v_and_b32 %0, 0, %0" : "+v"(zd));
#pragma unroll
        for (int vb = 0; vb < 3; ++vb)
#pragma unroll
            for (int u = 0; u < 4; ++u) P.gog[vb][u] = *(const u32x2*)(a.PROJ + (t0 + c0 + r) * LDP + C_GO + h * 96 + 32 * vb + 8 * u + 4 * hh + zd);
    }
}
__device__ __forceinline__ void gla3_post(LAS unsigned char* lds, const G3Args& a, const int ch, const int wave, const int lane, G3Pre& P) {
    const int r = lane & 31, hh = lane >> 5, h = wave >> 1, c0 = 32 * (wave & 1);
    const unsigned tra = (unsigned)(L_V + ((lane & 15) >> 2) * VSG + (((lane >> 4) & 1) * 16 + (lane & 3) * 4) * 2);
    {
        const size_t t0 = (size_t)ch * 64;
        bf16x8 sf[3][3];
#pragma unroll
        for (int vb = 0; vb < 3; ++vb)
#pragma unroll
            for (int ks = 0; ks < 3; ++ks) sf[vb][ks] = *(const bf16x8*)(a.STB + (((size_t)ch * 4 + h) * 96 + 32 * vb + r) * 48 + 16 * ks + 8 * hh);
        __syncthreads();
        f32x16 o[3];
#pragma unroll
        for (int vb = 0; vb < 3; ++vb)
#pragma unroll
            for (int i = 0; i < 16; ++i) o[vb][i] = 0.f;
#pragma unroll
        for (int sb = 0; sb < 2; ++sb)
#pragma unroll
            for (int s2 = 0; s2 < 2; ++s2) { const bf16x8 pb = pack_step(P.att[sb], s2);
                const unsigned a_lo = tra + (unsigned)((32 * sb + 16 * s2 + 4 * hh) * VSG + h * 96 * 2);
#pragma unroll
                for (int vb = 0; vb < 3; ++vb) { s16x4 lo, hi; tr_read2(lo, hi, a_lo + 64 * vb, a_lo + 64 * vb + 8 * VSG);
                    o[vb] = __builtin_amdgcn_mfma_f32_32x32x16_bf16(__builtin_shufflevector(lo, hi, 0, 1, 2, 3, 4, 5, 6, 7), pb, o[vb], 0, 0, 0); } }
#pragma unroll
        for (int vb = 0; vb < 3; ++vb)
#pragma unroll
            for (int ks = 0; ks < 3; ++ks) o[vb] = __builtin_amdgcn_mfma_f32_32x32x16_bf16(sf[vb][ks], P.qd[ks], o[vb], 0, 0, 0);
        float ss = 0.f;
#pragma unroll
        for (int vb = 0; vb < 3; ++vb)
#pragma unroll
            for (int i = 0; i < 16; ++i) ss += o[vb][i] * o[vb][i];
        ss += partner32(ss, hh);
        const float rs = 1.0f / sqrtf(ss * (1.0f / 96.0f) + 1e-6f);
        const size_t row = t0 + c0 + r;
#pragma unroll
        for (int vb = 0; vb < 3; ++vb)
#pragma unroll
            for (int u = 0; u < 4; ++u) { const int v0 = 32 * vb + 8 * u + 4 * hh; const u32x2 go = P.gog[vb][u]; const f32x4 ng = *(const f32x4*)(a.norm_g + v0);
                const float g0 = bflo(go.x), g1 = bfhi(go.x), g2 = bflo(go.y), g3 = bfhi(go.y);
                const float y0 = o[vb][4 * u] * rs * ng.x * g0 * __builtin_amdgcn_rcpf(1.0f + __expf(-g0)), y1 = o[vb][4 * u + 1] * rs * ng.y * g1 * __builtin_amdgcn_rcpf(1.0f + __expf(-g1));
                const float y2 = o[vb][4 * u + 2] * rs * ng.z * g2 * __builtin_amdgcn_rcpf(1.0f + __expf(-g2)), y3 = o[vb][4 * u + 3] * rs * ng.w * g3 * __builtin_amdgcn_rcpf(1.0f + __expf(-g3));
                u32x2 w; w.x = cvtpk(y0, y1); w.y = cvtpk(y2, y3); *(u32x2*)(a.MIX + row * 1024 + h * 96 + v0) = w; }
    }
}
__device__ __forceinline__ void gla3_phase(LAS unsigned char* lds, const G3Args& a, const int vcu, const int G, const int wave, const int lane, const int tid, G3Pre& P) {
    for (int ch = vcu; ch < 256; ch += G) {
        if (ch != vcu) gla3_pre(lds, a, ch, wave, lane, tid, P);
        gla3_post(lds, a, ch, wave, lane, P);
    }
}
}

#define XB_TMO      128
#define XB_XCNT(j)  (256  + 64 * (j))
#define XB_XSUB(j)  (1280 + 64 * (j))
#define XB_XGEN(j)  (2304 + 64 * (j))
#define XB_TOP      3328
#define XB_TOPGEN   3392
#define XCD_BAR_WORDS 3456
#define XB_SPIN_CAP (1u << 22)
__device__ __forceinline__ unsigned xb_ld(unsigned* p)              { return __hip_atomic_load(p, __ATOMIC_RELAXED, __HIP_MEMORY_SCOPE_AGENT); }
__device__ __forceinline__ unsigned xb_add(unsigned* p, unsigned v) { return __hip_atomic_fetch_add(p, v, __ATOMIC_RELAXED, __HIP_MEMORY_SCOPE_AGENT); }
__device__ __forceinline__ unsigned xb_xcc_id() { return (unsigned)__builtin_amdgcn_s_getreg((3 << 11) | 20) & 0xFu; }
#define XB_SPIN(cond, bar) do { unsigned _sp = 0; while (cond) { __builtin_amdgcn_s_sleep(1); \
    if ((++_sp & 255u) == 0u) { if (xb_ld(&(bar)[XB_TMO])) break; if (_sp > XB_SPIN_CAP) { atomicAdd(&(bar)[XB_TMO], 1u); break; } } } } while (0)
struct XcdBarrier { unsigned* bar; unsigned x; volatile LAS unsigned* st; };
__device__ __forceinline__ XcdBarrier xcd_barrier_post(unsigned* bar, volatile LAS unsigned* st) {
    XcdBarrier b; b.bar = bar; b.x = xb_xcc_id(); b.st = st;
    if (threadIdx.x == 0) (void)xb_add(&bar[XB_XCNT(b.x)], 1u);
    return b;
}
__device__ __forceinline__ void xcd_barrier_complete(unsigned* bar, unsigned x, unsigned& nloc, unsigned& nx) {
    const unsigned G = gridDim.x * gridDim.y * gridDim.z;
    unsigned sum, cnt, mine, sp = 0u;
    for (;;) {
        sum = 0u; cnt = 0u; mine = 0u;
#pragma unroll
        for (unsigned j = 0; j < 16; ++j) { const unsigned c = xb_ld(&bar[XB_XCNT(j)]); sum += c; cnt += (c > 0u) ? 1u : 0u; mine = (j == x) ? c : mine; }
        if (sum == G) break;
        __builtin_amdgcn_s_sleep(1);
        if ((++sp & 255u) == 0u) { if (xb_ld(&bar[XB_TMO])) break; if (sp > XB_SPIN_CAP) { atomicAdd(&bar[XB_TMO], 1u); break; } }
    }
    nloc = mine > 0u ? mine : 1u; nx = cnt > 0u ? cnt : 1u;
}
__device__ __forceinline__ void xcd_barrier(const XcdBarrier& b) {
    asm volatile("s_waitcnt vmcnt(0)" ::: "memory");
    __syncthreads();
    if (threadIdx.x == 0) {
        unsigned* bar = b.bar;
        __builtin_amdgcn_s_waitcnt(0);
        unsigned nloc = b.st[0], nx = b.st[1];
        if (nloc == 0u) { xcd_barrier_complete(bar, b.x, nloc, nx); b.st[0] = nloc; b.st[1] = nx; }
        const unsigned old = xb_add(&bar[XB_XSUB(b.x)], 1u);
        const unsigned gen = old / nloc;
        if (old + 1u == (gen + 1u) * nloc) {
            __builtin_amdgcn_fence(__ATOMIC_RELEASE, "agent");
            asm volatile("s_waitcnt vmcnt(0)" ::: "memory");
            const unsigned og = xb_add(&bar[XB_TOP], 1u);
            const unsigned tg = og / nx;
            if (og + 1u == (tg + 1u) * nx) xb_add(&bar[XB_TOPGEN], 1u);
            else XB_SPIN(xb_ld(&bar[XB_TOPGEN]) == tg, bar);
            __builtin_amdgcn_fence(__ATOMIC_ACQUIRE, "agent");
            xb_add(&bar[XB_XGEN(b.x)], 1u);
            asm volatile("s_waitcnt vmcnt(0)" ::: "memory");
        } else {
            XB_SPIN(xb_ld(&bar[XB_XGEN(b.x)]) == gen, bar);
            __builtin_amdgcn_fence(__ATOMIC_ACQUIRE, "agent");
            asm volatile("s_waitcnt vmcnt(0)" ::: "memory");
        }
    }
    __syncthreads();
}

constexpr int NTHREADS = 512, NWAVES = 8;
constexpr int LDS_MISC = 151552 - 1024;
constexpr int LDS_BYTES = 151552;
constexpr int T_ = 16384, D_ = 1024, LDP_ = 2816, NSLOT = 41216  ;
typedef unsigned short bf16;
typedef float f32x4 __attribute__((ext_vector_type(4)));
typedef float f32x2 __attribute__((ext_vector_type(2)));
typedef unsigned v4u __attribute__((ext_vector_type(4)));
typedef unsigned v2u __attribute__((ext_vector_type(2)));
constexpr size_t al256(size_t x) { return (x + 255) & ~(size_t)255; }
constexpr size_t OFF_CTL = 0, CTL_BYTES = 65536;
constexpr int CW_CNT = 4096, CW_FILL = 4096 + 1024, CW_RDY = 8192;
constexpr int CW_FIN = 14880;
constexpr int CW_TMO = 16000;
constexpr size_t OFF_WIN = CTL_BYTES;
constexpr size_t OFF_WOUT = OFF_WIN + (size_t)LDP_ * D_ * 2;
constexpr size_t OFF_WGU = OFF_WOUT + (size_t)D_ * D_ * 2;
constexpr size_t OFF_WD = OFF_WGU + (size_t)32 * 512 * D_ * 2;
constexpr size_t OFF_WPG = OFF_WD + (size_t)32 * D_ * 256 * 2;
constexpr size_t OFF_WPP = OFF_WPG + (size_t)D_ * D_ * 2;
constexpr size_t OFF_WR = OFF_WPP + (size_t)D_ * 256 * 2;
constexpr size_t OFF_HB = OFF_WR + (size_t)128 * 1024 * 2;
constexpr size_t OFF_PB = OFF_HB + (size_t)2 * T_ * D_ * 2;
constexpr size_t OFF_PROJ = OFF_PB + (size_t)T_ * 256 * 2;
constexpr size_t OFF_HID = OFF_PROJ;
constexpr size_t OFF_Y = OFF_HID + (size_t)NSLOT * 256 * 2;
constexpr size_t OFF_MIX = OFF_PROJ + (size_t)T_ * LDP_ * 2;
constexpr size_t OFF_EB = OFF_MIX + (size_t)T_ * D_ * 2;
constexpr size_t OFF_RSTD = OFF_EB + (size_t)T_ * D_ * 2;
constexpr size_t OFF_SS = OFF_RSTD + (size_t)3 * T_ * 4;
constexpr size_t OFF_QD = OFF_SS + (size_t)T_ * 16 * 4;
constexpr size_t OFF_KI = OFF_QD + (size_t)T_ * 192 * 2;
constexpr size_t OFF_KVT = OFF_KI + (size_t)T_ * 192 * 2;
constexpr size_t OFF_DEC = OFF_KVT + (size_t)256 * 4 * 96 * 48 * 4;
constexpr size_t OFF_STB = OFF_DEC + (size_t)256 * 192 * 4;
constexpr size_t OFF_WPL = OFF_STB + (size_t)256 * 4 * 96 * 48 * 2;
constexpr size_t OB_PB = 0, OB_WPP = (size_t)T_ * 1024 * 2;
constexpr size_t WS_END = OFF_WPL + (size_t)4 * 64 * 64 * 2;
constexpr int VCAP = T_;
constexpr size_t OFF_VTOK = OFF_KVT, OFF_VW = OFF_VTOK + (size_t)32 * VCAP * 4;
static_assert(OFF_VW + (size_t)32 * VCAP * 4 <= OFF_DEC, "virtual slot lists fit in the KVT region");
static_assert(OFF_Y + ((size_t)2 * T_ + 1) * D_ * 2 <= OFF_MIX, "HID | Y (+ one trash row) fit in the PROJ region");

__device__ __forceinline__ unsigned f2bf(float f) { unsigned u = __float_as_uint(f); return (u + 0x7fffu + ((u >> 16) & 1u)) >> 16; }
__device__ __forceinline__ unsigned pk2(float lo, float hi) { return f2bf(lo) | (f2bf(hi) << 16); }
__device__ __forceinline__ float bflo(unsigned u) { return __uint_as_float(u << 16); }
__device__ __forceinline__ float bfhi(unsigned u) { return __uint_as_float(u & 0xffff0000u); }
template <class T> __device__ __forceinline__ T* launder(T* p) { asm volatile("" : "+s"(p)); return p; }
__device__ __forceinline__ int hw_lane() { unsigned m = ~0u; asm volatile("" : "+s"(m)); return (int)__builtin_amdgcn_mbcnt_hi(m, __builtin_amdgcn_mbcnt_lo(m, 0u)); }
template <int XOR> __device__ __forceinline__ float swz_xor(float v) { return __int_as_float(__builtin_amdgcn_ds_swizzle(__float_as_int(v), (XOR << 10) | 0x1f)); }
__device__ __forceinline__ float xor32_sum(float v) { const auto r = __builtin_amdgcn_permlane32_swap(__float_as_uint(v), __float_as_uint(v), false, false); return __uint_as_float(r[0]) + __uint_as_float(r[1]); }
__device__ __forceinline__ float wave_sum(float v) {
    v += swz_xor<1>(v); v += swz_xor<2>(v); v += swz_xor<4>(v); v += swz_xor<8>(v); v += swz_xor<16>(v);
    return xor32_sum(v);
}
__device__ __forceinline__ float fsigmoid(float x) { return __builtin_amdgcn_rcpf(1.0f + __expf(-x)); }

struct TItem { const float* W; const float* g; bf16* WT; int N, ldt, dst_row0, kb, nb; };
__device__ __forceinline__ void titem_load(const TItem& t, f32x4 (&v)[8], float (&gg)[8], int lane) {
    const int k0 = 64 * t.kb, n0 = 32 * t.nb; const int c4 = lane & 7, kr = lane >> 3; const int n = n0 + 4 * c4;
#pragma unroll
    for (int i = 0; i < 8; ++i) { const int kk = 8 * i + kr; v[i] = (n < t.N) ? *(const f32x4*)(t.W + (size_t)(k0 + kk) * t.N + n) : (f32x4){0.f, 0.f, 0.f, 0.f}; gg[i] = t.g ? t.g[k0 + kk] : 1.0f; }
}
__device__ __forceinline__ void titem_finish(const TItem& t, const f32x4 (&v)[8], const float (&gg)[8], LAS float* scr, int lane) {
    const int k0 = 64 * t.kb; const int c4 = lane & 7, kr = lane >> 3;
#pragma unroll
    for (int i = 0; i < 8; ++i) { const int kk = 8 * i + kr; LAS float* d = scr + kk * 33 + 4 * c4; d[0] = v[i].x * gg[i]; d[1] = v[i].y * gg[i]; d[2] = v[i].z * gg[i]; d[3] = v[i].w * gg[i]; }
    asm volatile("s_waitcnt lgkmcnt(0)" ::: "memory");
    const int c = lane & 7;
#pragma unroll
    for (int j = 0; j < 4; ++j) { const int nn = (lane >> 3) + 8 * j; const LAS float* s = scr + (8 * c) * 33 + nn;
        v4u o; o.x = pk2(s[0 * 33], s[1 * 33]); o.y = pk2(s[2 * 33], s[3 * 33]); o.z = pk2(s[4 * 33], s[5 * 33]); o.w = pk2(s[6 * 33], s[7 * 33]);
        *(v4u*)(t.WT + (size_t)(t.dst_row0 + nn) * t.ldt + k0 + 8 * c) = o; }
    asm volatile("s_waitcnt lgkmcnt(0)" ::: "memory");
}
__device__ __forceinline__ void transpose_item(const float* W, const float* g, int K, int N, bf16* WT, int dst_row0, LAS float* scr, int kb, int nb, int lane, int ldt = 0) {
    if (ldt == 0) ldt = K;
    const int k0 = 64 * kb, n0 = 32 * nb; const int c4 = lane & 7, kr = lane >> 3; const int n = n0 + 4 * c4;
    f32x4 v[8]; float gg[8];
#pragma unroll
    for (int i = 0; i < 8; ++i) { const int kk = 8 * i + kr; v[i] = (n < N) ? *(const f32x4*)(W + (size_t)(k0 + kk) * N + n) : (f32x4){0.f, 0.f, 0.f, 0.f}; gg[i] = g ? g[k0 + kk] : 1.0f; }
#pragma unroll
    for (int i = 0; i < 8; ++i) { const int kk = 8 * i + kr; LAS float* d = scr + kk * 33 + 4 * c4; d[0] = v[i].x * gg[i]; d[1] = v[i].y * gg[i]; d[2] = v[i].z * gg[i]; d[3] = v[i].w * gg[i]; }
    asm volatile("s_waitcnt lgkmcnt(0)" ::: "memory");
    const int c = lane & 7;
#pragma unroll
    for (int j = 0; j < 4; ++j) { const int nn = (lane >> 3) + 8 * j; const LAS float* s = scr + (8 * c) * 33 + nn;
        v4u o; o.x = pk2(s[0 * 33], s[1 * 33]); o.y = pk2(s[2 * 33], s[3 * 33]); o.z = pk2(s[4 * 33], s[5 * 33]); o.w = pk2(s[6 * 33], s[7 * 33]);
        *(v4u*)(WT + (size_t)(dst_row0 + nn) * ldt + k0 + 8 * c) = o; }
    asm volatile("s_waitcnt lgkmcnt(0)" ::: "memory");
}
__device__ __forceinline__ void row_to_bf16_rstd(const float* xrow, bf16* orow, float* rstd, int lane) {
    const f32x4* xr = (const f32x4*)xrow + lane;
    f32x4 v[4]; float s = 0.f;
#pragma unroll
    for (int j = 0; j < 4; ++j) { v[j] = xr[64 * j]; s += (v[j].x * v[j].x + v[j].y * v[j].y) + (v[j].z * v[j].z + v[j].w * v[j].w); }
    s = wave_sum(s);
    if (lane == 0) *rstd = 1.0f / sqrtf(s * (1.0f / 1024.0f) + 1e-6f);
    unsigned long long* o8 = (unsigned long long*)orow + lane;
#pragma unroll
    for (int j = 0; j < 4; ++j) o8[64 * j] = (unsigned long long)pk2(v[j].x, v[j].y) | ((unsigned long long)pk2(v[j].z, v[j].w) << 32);
}

struct LayerIn { const float *x, *pl, *norm1_g, *w_in, *w_out, *norm2_g, *rg_w, *re_w, *wg, *wu, *wd, *ple_g, *ple_w, *ple_p, *pool_w; };
template <int MODE> __device__ __forceinline__ void prologue_phase(LAS unsigned char* lds, const LayerIn& I, unsigned char* ws, unsigned char* obuf, int l, int gw, int NGW, int wave, int lane, int gtid, int GT) {
    LAS float* scr = (LAS float*)(lds + wave * 16384);
    if (MODE == 0 && l == 0) { float* RSTD1 = (float*)(ws + OFF_RSTD); bf16* Hb = (bf16*)(ws + OFF_HB);
        for (int m0 = gw; m0 < T_; m0 += 4 * NGW) {
            f32x4 v[4][4]; float ss[4];
#pragma unroll
            for (int q = 0; q < 4; ++q) { const int m = m0 + q * NGW; const f32x4* xr = (const f32x4*)(I.x + (size_t)(m < T_ ? m : m0) * 1024) + lane;
#pragma unroll
                for (int j = 0; j < 4; ++j) v[q][j] = xr[64 * j]; }
#pragma unroll
            for (int q = 0; q < 4; ++q) { float s = 0.f;
#pragma unroll
                for (int j = 0; j < 4; ++j) s += (v[q][j].x * v[q][j].x + v[q][j].y * v[q][j].y) + (v[q][j].z * v[q][j].z + v[q][j].w * v[q][j].w);
                ss[q] = s; }
#pragma unroll
            for (int q = 0; q < 4; ++q) ss[q] = wave_sum(ss[q]);
#pragma unroll
            for (int q = 0; q < 4; ++q) { const int m = m0 + q * NGW; if (m < T_) { if (lane == 0) RSTD1[m] = 1.0f / sqrtf(ss[q] * (1.0f / 1024.0f) + 1e-6f);
                unsigned long long* o8 = (unsigned long long*)(Hb + (size_t)m * 1024) + lane;
#pragma unroll
                for (int j = 0; j < 4; ++j) o8[64 * j] = (unsigned long long)pk2(v[q][j].x, v[q][j].y) | ((unsigned long long)pk2(v[q][j].z, v[q][j].w) << 32); } } } }
    if constexpr (MODE != 2) {
    bf16* WinT = (bf16*)(ws + OFF_WIN); bf16* WoutT = (bf16*)(ws + OFF_WOUT); bf16* WguT = (bf16*)(ws + OFF_WGU); bf16* WdT = (bf16*)(ws + OFF_WD); bf16* WpgT = (bf16*)(ws + ((l & 1) ? OFF_PB : OFF_WPG));        bf16* WppT = (bf16*)(obuf + OB_WPP);
    constexpr int I_IN = 16 * 88, I_OUT = 16 * 32, I_GU = 32 * 2 * 16 * 8, I_D = 32 * 4 * 32, I_PG = 16 * 32, I_PP = 4 * 32;
    constexpr int NITEMS = I_IN + I_OUT + I_GU + I_D + I_PG + I_PP;
    auto decode = [&](int it) -> TItem {
        int r = it;
        if (r < I_IN) return TItem{I.w_in, I.norm1_g, WinT, 2576, 1024, (r % 88) * 32, r / 88, r % 88}; r -= I_IN;
        if (r < I_OUT) return TItem{I.w_out, nullptr, WoutT, 1024, 1024, (r % 32) * 32, r / 32, r % 32}; r -= I_OUT;
        if (r < I_GU) { const int e = r / 256, q = r % 256, up = q / 128, kb = (q % 128) / 8, nb = q % 8;
            return TItem{(up ? I.wu : I.wg) + (size_t)e * 1024 * 256, I.norm2_g, WguT + (size_t)e * 512 * 1024, 256, 1024, (nb / 4) * 256 + up * 128 + (nb % 4) * 32, kb, nb}; } r -= I_GU;
        if (r < I_D) { const int e = r / 128, q = r % 128; return TItem{I.wd + (size_t)e * 256 * 1024, nullptr, WdT + (size_t)e * 1024 * 256, 1024, 256, (q % 32) * 32, q / 32, q % 32}; } r -= I_D;
        if (r < I_PG) return TItem{I.ple_w, I.ple_g, WpgT, 1024, 1024, (r % 32) * 32, r / 32, r % 32}; r -= I_PG;
        return TItem{I.ple_p, nullptr, WppT, 1024, 1024, (r % 32) * 32, r / 32, r % 32};
    };
    if (gw < NITEMS) {
        TItem cur = decode(gw); f32x4 v[8]; float gg[8];
        titem_load(cur, v, gg, lane);
        for (int it = gw; it < NITEMS; it += NGW) {
            const bool more = it + NGW < NITEMS;
            TItem nxt = cur; f32x4 vn[8]; float gn[8];
            if (more) { nxt = decode(it + NGW); titem_load(nxt, vn, gn, lane); }
            titem_finish(cur, v, gg, scr, lane);
            if (more) { cur = nxt;
#pragma unroll
                for (int i = 0; i < 8; ++i) { v[i] = vn[i]; gg[i] = gn[i]; } }
        }
    }
    { bf16* WR = (bf16*)(ws + OFF_WR);
      for (int i = gtid; i < 128 * 1024; i += GT) { const int k = i & 1023, n = i >> 10; const int blk = n >> 5, rr = n & 31; const int j = (blk < 2) ? rr : 32 + rr; const bool lo = blk & 1;
          unsigned o = 0u;
          if (blk < 2 || rr < 4) { const float w = I.norm2_g[k] * (j < 4 ? I.rg_w[k * 4 + j] : I.re_w[k * 32 + (j - 4)]); const unsigned hi = f2bf(w); o = lo ? f2bf(w - bflo(hi)) : hi; }
          WR[i] = (bf16)o; } }
    { bf16* WPL = (bf16*)(ws + OFF_WPL); for (int i = gtid; i < 4 * 64 * 64; i += GT) { const int c = i & 63, d = (i >> 6) & 63, g = i >> 12; WPL[i] = (bf16)f2bf(I.pool_w[(g * 64 + c) * 64 + d]); } }
    bf16* Pb = (bf16*)(obuf + OB_PB);
    { f32x4 v[8];
#pragma unroll
      for (int u = 0; u < 8; ++u) v[u] = ((const f32x4*)I.pl)[gtid + u * GT];
#pragma unroll
      for (int u = 0; u < 8; ++u) { const int i4 = gtid + u * GT, row = i4 >> 6, c4 = i4 & 63; v2u o; o.x = pk2(v[u].x, v[u].y); o.y = pk2(v[u].z, v[u].w); *(v2u*)(Pb + (size_t)row * 1024 + 4 * c4) = o; } }
    }
    if constexpr (MODE == 2)
    if (l != 0) { float* RSTD1 = (float*)(ws + OFF_RSTD);
      { const float* SS = (const float*)(ws + OFF_SS);
        for (int m = gtid; m < T_; m += GT) { const f32x4* s4 = (const f32x4*)(SS + (size_t)m * 16); const f32x4 a = s4[0], b = s4[1], c = s4[2], d = s4[3];
            const float s = ((a.x + a.y) + (a.z + a.w)) + ((b.x + b.y) + (b.z + b.w)) + ((c.x + c.y) + (c.z + c.w)) + ((d.x + d.y) + (d.z + d.w));
            RSTD1[m] = 1.0f / sqrtf(s * (1.0f / 1024.0f) + 1e-6f); } } }
}

struct PlainSched {
    static constexpr bool GATHER = false, HOOKS = false, SKIPHI = false;
    int nM, nN, nwg, G, c, nt; const char* A; const char* Bt; size_t astep, bstep;
    __device__ __forceinline__ void init(const void* A_, const void* Bt_, int M, int N, int K, int lda, int ldb, int G_, int c_) {
        nM = M / 256; nN = N / 256; nwg = nM * nN; G = G_; c = c_; nt = K / 64; A = (const char*)A_; Bt = (const char*)Bt_; astep = (size_t)256 * lda * 2; bstep = (size_t)256 * ldb * 2; }
    __device__ __forceinline__ bool next(int i, gp::Unit& u) const {
        const long L = (long)i * G + c; if (L >= nwg) return false;
        int wgid = (int)L; { const int q = nwg / 8, r = nwg % 8, xcd = wgid % 8, off = wgid / 8; wgid = (xcd < r ? xcd * (q + 1) : r * (q + 1) + (xcd - r) * q) + off; }
        const int nig = 8 * nN, gid = wgid / nig, fm = gid * 8, gsz = (nM - fm) < 8 ? (nM - fm) : 8;
        u.pm = fm + ((wgid % nig) % gsz); u.pn = (wgid % nig) / gsz; u.aB = A + (size_t)u.pm * astep; u.bB = Bt + (size_t)u.pn * bstep; u.nt = nt; u.rl = nullptr; u.aux = 0; return true;
    }
};
struct ProjESched {
    static constexpr bool GATHER = false, HOOKS = false, SKIPHI = false;
    PlainSched P; const char* A2; const char* B2; int G, c, nfull, spare;
    __device__ __forceinline__ void init(const void* A, const void* Bt, const void* A2_, const void* B2_, int G_, int c_) {
        P.init(A, Bt, T_, LDP_, 1024, 1024, 1024, G_, c_); A2 = (const char*)A2_; B2 = (const char*)B2_; G = G_; c = c_;
        nfull = (P.nwg - c + G - 1) / G;
        const int rounds = (P.nwg + G - 1) / G; spare = (nfull < rounds) ? 1 : 0; }
    __device__ __forceinline__ bool next(int i, gp::Unit& u) const {
        if (i < nfull) return P.next(i, u);
        const int rounds = (P.nwg + G - 1) / G, first_spare = P.nwg - (rounds - 1) * G, nspare = G - first_spare;
        int e = -1; const int j = i - nfull;
        if (spare) { if (j < 4) e = (c - first_spare) * 4 + j; else if (4 * nspare < 256) { const long L = (long)(j - 4) * G + c + 4 * nspare; if (L < 256) e = (int)L; } }
        else if (4 * nspare < 256) { const long L = (long)j * G + c + 4 * nspare; if (L < 256) e = (int)L; }
        if (e < 0 || e >= 256) return false;
        u.pm = e >> 2; u.pn = e & 3; u.aB = A2 + (size_t)u.pm * 256 * 1024 * 2; u.bB = B2 + (size_t)u.pn * 256 * 1024 * 2; u.nt = 4; u.rl = nullptr; u.aux = 1; return true;
    }
};
__device__ __forceinline__ int toff_at(const volatile LAS int* toffs, int j) { unsigned o = 4u * (unsigned)j; asm volatile("" : "+v"(o)); return __builtin_amdgcn_readfirstlane(*(const volatile LAS int*)((const volatile LAS char*)toffs + o)); }
__device__ __forceinline__ int moe_ntile(const volatile LAS int* toffs) { const int w = toff_at(toffs, 32); return (w & 0xff) + ((w >> 8) & 0xff); }
__device__ __forceinline__ void moe_tile(const volatile LAS int* toffs, const int rt, int& e, int& tl, int& nv) {
    const int NN = toff_at(toffs, 32) & 0xff; int ee = 0;
    if (rt < NN) {
        for (int j = 1; j < 32; ++j) ee += (rt >= (toff_at(toffs, j) & 0xff)) ? 1 : 0;
        ee = __builtin_amdgcn_readfirstlane(ee);
        const int w = toff_at(toffs, ee), cnt = (w >> 8) & 0x7fff; tl = rt - (w & 0xff); nv = min(256, cnt - 256 * tl);
    } else {
        const int k = rt - NN;
        for (int j = 1; j < 32; ++j) ee += (k >= ((toff_at(toffs, j) >> 23) & 0x3f)) ? 1 : 0;
        ee = __builtin_amdgcn_readfirstlane(ee);
        const int cnt = (toff_at(toffs, ee) >> 8) & 0x7fff; tl = cnt >> 8; nv = cnt & 255;
    }
    e = ee;
}
struct MoeUpSched {
    static constexpr bool GATHER = true, HOOKS = true, SKIPHI = true;
    const volatile LAS int* toffs; int G, c; const char* A; const char* Bt; const int* lrow; unsigned* ready;
    __device__ __forceinline__ bool next(int i, gp::Unit& u) const {
        const int ntile = moe_ntile(toffs);
        const long L = (long)i * G + c; if (L >= (long)ntile * 2) return false;
        const int rt = (int)(L >> 1), pn = (int)(L & 1); int e, tl, nv;
        moe_tile(toffs, rt, e, tl, nv);
        u.pm = rt; u.pn = pn; u.aux = nv; u.rl = lrow + (size_t)e * VCAP + (size_t)tl * 256; u.aB = A; u.bB = Bt + ((size_t)e * 512 + (size_t)pn * 256) * 1024 * 2; u.nt = 16; return true;
    }
    __device__ __forceinline__ unsigned arow(const gp::Unit& u, int i) const { const int v = u.rl[i]; return i < u.aux ? (unsigned)(v >> 1) : 0u; }
    __device__ __forceinline__ void a_ready(const gp::Unit&) const {}
    __device__ __forceinline__ void done(const gp::Unit& u) const {
        asm volatile("s_waitcnt vmcnt(0)" ::: "memory");
        if (hw_lane() == 0) __hip_atomic_fetch_add(ready + 16 * u.pm, 1u, __ATOMIC_RELAXED, __HIP_MEMORY_SCOPE_AGENT);
    }
};
template <bool LATE> struct MoeDownSched {
    static constexpr bool GATHER = false, HOOKS = false, SKIPHI = true;
    const volatile LAS int* toffs; int G, c; const char* A; const char* Bt; const int* vtok;
    __device__ __forceinline__ int unit_of(int i) const {
        const int ntile = moe_ntile(toffs); const int nU = 2 * ntile, nD = 4 * ntile;
        const int nEarlyT = (nU <= G) ? ntile : G / 2, nEarly = 4 * nEarlyT;
        if (!LATE) { const int nb = (nU > G) ? nU - G : 0;
            if (nb >= G) { const long d = (long)c + (long)i * G; return d < nEarly ? (int)d : -1; }
            if (c < nb) return -1;
            const int R = G - nb, q = nEarly / R, rem = nEarly % R, rk = c - nb;
            const int cntu = rk < rem ? q + 1 : q, first = rk < rem ? rk * (q + 1) : rem * (q + 1) + (rk - rem) * q;
            return i < cntu ? first + i : -1; }
        const int nb = (nU > G) ? nU - G : 0; long j;
        if (nb > 0 && nb < G) { const int R = G - nb, rem = nEarly % R; const int slot = (c >= nb) ? ((c - nb) - rem + R) % R : R + c; j = (long)slot + (long)i * G; }
        else j = (long)c + (long)i * G;
        const long d = (long)nEarly + j; return d < nD ? (int)d : -1;
    }
    __device__ __forceinline__ bool next(int i, gp::Unit& u) const {
        const int d = unit_of(i); if (d < 0) return false;
        const int rt = d >> 2, pn = d & 3; int e, tl, nv;
        moe_tile(toffs, rt, e, tl, nv);
        u.pm = rt; u.pn = pn; u.aux = nv; u.rl = vtok + (size_t)e * VCAP + (size_t)tl * 256; u.aB = A + (size_t)rt * 256 * 256 * 2; u.bB = Bt + ((size_t)e * 1024 + (size_t)pn * 256) * 256 * 2; u.nt = 4; return true;
    }
    __device__ __forceinline__ void wait_tiles(unsigned* ready, int wave) const {
        if (wave == 0) { for (int i = 0;; ++i) { const int d = unit_of(i); if (d < 0) break; unsigned* w = ready + 16 * (d >> 2); unsigned polls = 0;
            while ((unsigned)__builtin_amdgcn_readfirstlane(__hip_atomic_load(w, __ATOMIC_RELAXED, __HIP_MEMORY_SCOPE_AGENT)) < 16u && ++polls < (1u << 20)) __builtin_amdgcn_s_sleep(2); } }
        __syncthreads();
    }
};
__device__ __forceinline__ void compute_toffs(volatile LAS int* toffs, unsigned* cnt, int tid) {
    if (tid < 64) {
        const int c = (tid < 32) ? (int)__hip_atomic_load(cnt + tid, __ATOMIC_RELAXED, __HIP_MEMORY_SCOPE_AGENT) : 0;
        const int rem = c & 255, nrm = (c >> 8) + (rem > 128 ? 1 : 0), sml = (rem > 0 && rem <= 128) ? 1 : 0; int incl = nrm | (sml << 16);
#pragma unroll
        for (int o = 1; o < 32; o <<= 1) { const int v = __builtin_amdgcn_ds_bpermute((tid - o) << 2, incl); if (tid >= o) incl += v; }
        if (tid < 32) toffs[tid] = ((incl & 0xffff) - nrm) | (c << 8) | (((incl >> 16) - sml) << 23);
        if (tid == 31) toffs[32] = (incl & 0xffff) | ((incl >> 16) << 8);
    }
    __syncthreads();
}

template <bool FROM_SS> struct EpiProj {
    static constexpr bool PERM = true, PRE = false;
    bf16* O; const float* rstd;
    __device__ __forceinline__ void operator()(const gp::f32x4 (&acc)[2][2][4][2], const gp::Unit& u, int wr, int wc, int fr, int fq) const {
        const int row0 = u.pm * 256 + wr * 64 + fr, col0 = u.pn * 256 + wc * 32 + 8 * fq;
#pragma unroll
        for (int ai = 0; ai < 2; ++ai)
#pragma unroll
            for (int m = 0; m < 4; ++m) { const int row = row0 + ai * 128 + m * 16; float sc;
                if constexpr (FROM_SS) { const gp::f32x4 p4 = *(const gp::f32x4*)(rstd + (size_t)row * 16 + 4 * fq); float t = (p4[0] + p4[1]) + (p4[2] + p4[3]); t += swz_xor<16>(t); t = xor32_sum(t); sc = 1.0f / sqrtf(t * (1.0f / 1024.0f) + 1e-6f); }
                else sc = rstd[row];
                bf16* rowp = O + (size_t)row * LDP_ + col0;
#pragma unroll
                for (int bj = 0; bj < 2; ++bj) { const gp::f32x4 v0 = acc[ai][bj][m][0] * sc, v1 = acc[ai][bj][m][1] * sc;
                    gp::u32x4 w; w.x = gp::cvt_pk_bf16(v0[0], v0[1]); w.y = gp::cvt_pk_bf16(v0[2], v0[3]); w.z = gp::cvt_pk_bf16(v1[0], v1[1]); w.w = gp::cvt_pk_bf16(v1[2], v1[3]);
                    *(gp::u32x4*)(rowp + bj * 128) = w; } }
    }
};
struct EpiE {
    static constexpr bool PERM = true, PRE = false;
    bf16* O;
    __device__ __forceinline__ void operator()(const gp::f32x4 (&acc)[2][2][4][2], const gp::Unit& u, int wr, int wc, int fr, int fq) const {
        const int row0 = u.pm * 256 + wr * 64 + fr, col0 = u.pn * 256 + wc * 32 + 8 * fq;
#pragma unroll
        for (int ai = 0; ai < 2; ++ai)
#pragma unroll
            for (int m = 0; m < 4; ++m) { bf16* rowp = O + (size_t)(row0 + ai * 128 + m * 16) * 1024 + col0;
#pragma unroll
                for (int bj = 0; bj < 2; ++bj) { const gp::f32x4 v0 = acc[ai][bj][m][0], v1 = acc[ai][bj][m][1];
                    gp::u32x4 w; w.x = gp::cvt_pk_bf16(v0[0], v0[1]); w.y = gp::cvt_pk_bf16(v0[2], v0[3]); w.z = gp::cvt_pk_bf16(v1[0], v1[1]); w.w = gp::cvt_pk_bf16(v1[2], v1[3]);
                    *(gp::u32x4*)(rowp + bj * 128) = w; } }
    }
};
template <bool FROM_SS> struct EpiProjE {
    static constexpr bool PERM = true, PRE = false;
    EpiProj<FROM_SS> P; EpiE E;
    __device__ __forceinline__ void operator()(const gp::f32x4 (&acc)[2][2][4][2], const gp::Unit& u, int wr, int wc, int fr, int fq) const { if (u.aux) E(acc, u, wr, wc, fr, fq); else P(acc, u, wr, wc, fr, fq); }
};
struct EpiOut {
    static constexpr bool PERM = true, PRE = false;
    bf16* H;
    __device__ __forceinline__ void operator()(const gp::f32x4 (&acc)[2][2][4][2], const gp::Unit& u, int wr, int wc, int fr, int fq) const {
        const int row0 = u.pm * 256 + wr * 64 + fr, col0 = u.pn * 256 + wc * 32 + 8 * fq;
        gp::u32x4 p[2][4][2];
#pragma unroll
        for (int ai = 0; ai < 2; ++ai)
#pragma unroll
            for (int m = 0; m < 4; ++m)
#pragma unroll
                for (int bj = 0; bj < 2; ++bj) { const gp::f32x4 v0 = acc[ai][bj][m][0], v1 = acc[ai][bj][m][1];
                    p[ai][m][bj].x = gp::cvt_pk_bf16(v0[0], v0[1]); p[ai][m][bj].y = gp::cvt_pk_bf16(v0[2], v0[3]); p[ai][m][bj].z = gp::cvt_pk_bf16(v1[0], v1[1]); p[ai][m][bj].w = gp::cvt_pk_bf16(v1[2], v1[3]); }
        gp::u32x4 hb[2][4][2];
#pragma unroll
        for (int ai = 0; ai < 2; ++ai)
#pragma unroll
            for (int m = 0; m < 4; ++m)
#pragma unroll
                for (int bj = 0; bj < 2; ++bj) hb[ai][m][bj] = *(const gp::u32x4*)(H + (size_t)(row0 + ai * 128 + m * 16) * 1024 + col0 + bj * 128);
#pragma unroll
        for (int ai = 0; ai < 2; ++ai)
#pragma unroll
            for (int m = 0; m < 4; ++m)
#pragma unroll
                for (int bj = 0; bj < 2; ++bj) { const gp::u32x4 a = p[ai][m][bj], h = hb[ai][m][bj]; gp::u32x4 w;
#pragma unroll
                    for (int e = 0; e < 4; ++e) w[e] = gp::cvt_pk_bf16(bflo(h[e]) + bflo(a[e]), bfhi(h[e]) + bfhi(a[e]));
                    *(gp::u32x4*)(H + (size_t)(row0 + ai * 128 + m * 16) * 1024 + col0 + bj * 128) = w; }
    }
};
struct EpiUp {
    static constexpr bool PERM = true, PRE = false;
    bf16* HID; const float* rstd;
    __device__ __forceinline__ void operator()(const gp::f32x4 (&acc)[2][2][4][2], const gp::Unit& u, int wr, int wc, int fr, int fq) const {
        const int r0 = wr * 64 + fr, f0 = u.pn * 128 + wc * 32 + 8 * fq;
        float sc8[2][4], w8[2][4];
        { int lt8[2][4];
#pragma unroll
          for (int ai = 0; ai < 2; ++ai)
#pragma unroll
              for (int m = 0; m < 4; ++m) { const int r = r0 + ai * 128 + m * 16; const bool ok = r < u.aux; lt8[ai][m] = ok ? u.rl[r] : 0; w8[ai][m] = ok ? ((const float*)u.rl)[32 * VCAP + r] : 0.f; }
#pragma unroll
          for (int ai = 0; ai < 2; ++ai)
#pragma unroll
              for (int m = 0; m < 4; ++m) sc8[ai][m] = rstd[lt8[ai][m] >> 1]; }
#pragma unroll
        for (int ai = 0; ai < 2; ++ai)
#pragma unroll
            for (int m = 0; m < 4; ++m) { const int r = r0 + ai * 128 + m * 16, slot = u.pm * 256 + r; const float sc = sc8[ai][m], w = w8[ai][m];
                float h[8];
#pragma unroll
                for (int n = 0; n < 2; ++n)
#pragma unroll
                    for (int j = 0; j < 4; ++j) { const float a = acc[ai][0][m][n][j] * sc, b = acc[ai][1][m][n][j] * sc; h[4 * n + j] = a * fsigmoid(a) * b * w; }
                gp::u32x4 o; o.x = gp::cvt_pk_bf16(h[0], h[1]); o.y = gp::cvt_pk_bf16(h[2], h[3]); o.z = gp::cvt_pk_bf16(h[4], h[5]); o.w = gp::cvt_pk_bf16(h[6], h[7]);
                __builtin_amdgcn_raw_buffer_store_b128(o, __builtin_amdgcn_make_buffer_rsrc((void*)HID, 0, NSLOT * 512, 0x00020000), (slot * 256 + f0) * 2, 0, 16);
                asm volatile("" ::: "memory"); }
    }
};
struct EpiDown {
    static constexpr bool PERM = true, PRE = true;
    bf16* Y;
    __device__ __forceinline__ void prefetch(const gp::Unit& u, int wr, int fr, int (&lt8)[8]) const {
        const int r0 = wr * 64 + fr;
#pragma unroll
        for (int ai = 0; ai < 2; ++ai)
#pragma unroll
            for (int m = 0; m < 4; ++m) { const int r = r0 + ai * 128 + m * 16; lt8[ai * 4 + m] = r < u.aux ? u.rl[r] : -1; } }
    __device__ __forceinline__ void operator()(const gp::f32x4 (&acc)[2][2][4][2], const gp::Unit& u, int wr, int wc, int fr, int fq, const int (&pre)[8]) const {
        const int r0 = wr * 64 + fr, col0 = u.pn * 256 + wc * 32 + 8 * fq;
#pragma unroll
        for (int ai = 0; ai < 2; ++ai)
#pragma unroll
            for (int m = 0; m < 4; ++m) { const int lt = pre[ai * 4 + m];
                bf16* rowp = Y + (lt < 0 ? (size_t)2 * T_ : (size_t)(lt & 1) * T_ + (size_t)(lt >> 1)) * 1024 + col0;
#pragma unroll
                for (int bj = 0; bj < 2; ++bj) { const gp::f32x4 v0 = acc[ai][bj][m][0], v1 = acc[ai][bj][m][1];
                    gp::u32x4 w; w.x = gp::cvt_pk_bf16(v0[0], v0[1]); w.y = gp::cvt_pk_bf16(v0[2], v0[3]); w.z = gp::cvt_pk_bf16(v1[0], v1[1]); w.w = gp::cvt_pk_bf16(v1[2], v1[3]);
                    *(gp::u32x4*)(rowp + bj * 128) = w; }
                asm volatile("" ::: "memory"); }
    }
};
struct EpiPle {
    static constexpr bool PERM = true, PRE = false;
    const bf16* Hin; bf16* Hout; const bf16* Eb; const float* rstd; const float* bias; float* SS;
    __device__ __forceinline__ void operator()(const gp::f32x4 (&acc)[2][2][4][2], const gp::Unit& u, int wr, int wc, int fr, int fq) const {
        const int row0 = u.pm * 256 + wr * 64 + fr, col0 = u.pn * 256 + wc * 32 + 8 * fq;
        gp::u32x4 g[2][4][2];
        { gp::f32x4 bv[2][2]; float sc[2][4];
#pragma unroll
          for (int bj = 0; bj < 2; ++bj)
#pragma unroll
              for (int n = 0; n < 2; ++n) bv[bj][n] = *(const gp::f32x4*)(bias + col0 + bj * 128 + 4 * n);
#pragma unroll
          for (int ai = 0; ai < 2; ++ai)
#pragma unroll
              for (int m = 0; m < 4; ++m) sc[ai][m] = rstd[row0 + ai * 128 + m * 16];
#pragma unroll
          for (int ai = 0; ai < 2; ++ai)
#pragma unroll
              for (int m = 0; m < 4; ++m)
#pragma unroll
                  for (int bj = 0; bj < 2; ++bj) { const gp::f32x4 v0 = acc[ai][bj][m][0] * sc[ai][m] + bv[bj][0], v1 = acc[ai][bj][m][1] * sc[ai][m] + bv[bj][1];
                      g[ai][m][bj].x = gp::cvt_pk_bf16(fsigmoid(v0[0]), fsigmoid(v0[1])); g[ai][m][bj].y = gp::cvt_pk_bf16(fsigmoid(v0[2]), fsigmoid(v0[3]));
                      g[ai][m][bj].z = gp::cvt_pk_bf16(fsigmoid(v1[0]), fsigmoid(v1[1])); g[ai][m][bj].w = gp::cvt_pk_bf16(fsigmoid(v1[2]), fsigmoid(v1[3])); } }
#pragma unroll
        for (int ai = 0; ai < 2; ++ai) {
            gp::u32x4 hb[4][2], eb[4][2];
#pragma unroll
            for (int m = 0; m < 4; ++m)
#pragma unroll
                for (int bj = 0; bj < 2; ++bj) { const size_t off = (size_t)(row0 + ai * 128 + m * 16) * 1024 + col0 + bj * 128; hb[m][bj] = *(const gp::u32x4*)(Hin + off); eb[m][bj] = *(const gp::u32x4*)(Eb + off); }
#pragma unroll
            for (int m = 0; m < 4; ++m) { const int row = row0 + ai * 128 + m * 16; float ss = 0.f;
#pragma unroll
                for (int bj = 0; bj < 2; ++bj) { gp::u32x4 w;
#pragma unroll
                    for (int e = 0; e < 4; ++e) { w[e] = gp::cvt_pk_bf16(bflo(hb[m][bj][e]) + bflo(g[ai][m][bj][e]) * bflo(eb[m][bj][e]), bfhi(hb[m][bj][e]) + bfhi(g[ai][m][bj][e]) * bfhi(eb[m][bj][e]));
                        ss += bflo(w[e]) * bflo(w[e]) + bfhi(w[e]) * bfhi(w[e]); }
                    *(gp::u32x4*)(Hout + (size_t)row * 1024 + col0 + bj * 128) = w; }
                ss += swz_xor<16>(ss); ss = xor32_sum(ss);
                if (fq == 0) SS[(size_t)row * 16 + u.pn * 4 + wc] = ss; }
            asm volatile("" ::: "memory"); }
    }
};

struct EpiPleFinal {
    static constexpr bool PERM = true, PRE = false;
    const bf16* Hin; const bf16* Eb; const float* rstd; const float* bias; float* SS; unsigned* fin; const float* fg; float* out;
    __device__ __forceinline__ void operator()(const gp::f32x4 (&acc)[2][2][4][2], const gp::Unit& u, int wr, int wc, int fr, int fq) const {
        const int row0 = u.pm * 256 + wr * 64 + fr, col0 = u.pn * 256 + wc * 32 + 8 * fq;
        gp::u32x4 g[2][4][2];
        { gp::f32x4 bv[2][2]; float sc[2][4];
#pragma unroll
          for (int bj = 0; bj < 2; ++bj)
#pragma unroll
              for (int n = 0; n < 2; ++n) bv[bj][n] = *(const gp::f32x4*)(bias + col0 + bj * 128 + 4 * n);
#pragma unroll
          for (int ai = 0; ai < 2; ++ai)
#pragma unroll
              for (int m = 0; m < 4; ++m) sc[ai][m] = rstd[row0 + ai * 128 + m * 16];
#pragma unroll
          for (int ai = 0; ai < 2; ++ai)
#pragma unroll
              for (int m = 0; m < 4; ++m)
#pragma unroll
                  for (int bj = 0; bj < 2; ++bj) { const gp::f32x4 v0 = acc[ai][bj][m][0] * sc[ai][m] + bv[bj][0], v1 = acc[ai][bj][m][1] * sc[ai][m] + bv[bj][1];
                      g[ai][m][bj].x = gp::cvt_pk_bf16(fsigmoid(v0[0]), fsigmoid(v0[1])); g[ai][m][bj].y = gp::cvt_pk_bf16(fsigmoid(v0[2]), fsigmoid(v0[3]));
                      g[ai][m][bj].z = gp::cvt_pk_bf16(fsigmoid(v1[0]), fsigmoid(v1[1])); g[ai][m][bj].w = gp::cvt_pk_bf16(fsigmoid(v1[2]), fsigmoid(v1[3])); } }
        const auto ssrc = __builtin_amdgcn_make_buffer_rsrc((void*)SS, 0, T_ * 64, 0x00020000);
#pragma unroll
        for (int ai = 0; ai < 2; ++ai) {
            gp::u32x4 hb[4][2], eb[4][2];
#pragma unroll
            for (int m = 0; m < 4; ++m)
#pragma unroll
                for (int bj = 0; bj < 2; ++bj) { const size_t off = (size_t)(row0 + ai * 128 + m * 16) * 1024 + col0 + bj * 128; hb[m][bj] = *(const gp::u32x4*)(Hin + off); eb[m][bj] = *(const gp::u32x4*)(Eb + off); }
#pragma unroll
            for (int m = 0; m < 4; ++m) { const int row = row0 + ai * 128 + m * 16; float ss = 0.f;
#pragma unroll
                for (int bj = 0; bj < 2; ++bj) { gp::u32x4 w;
#pragma unroll
                    for (int e = 0; e < 4; ++e) { w[e] = gp::cvt_pk_bf16(bflo(hb[m][bj][e]) + bflo(g[ai][m][bj][e]) * bflo(eb[m][bj][e]), bfhi(hb[m][bj][e]) + bfhi(g[ai][m][bj][e]) * bfhi(eb[m][bj][e]));
                        ss += bflo(w[e]) * bflo(w[e]) + bfhi(w[e]) * bfhi(w[e]); }
                    g[ai][m][bj] = w; }
                ss += swz_xor<16>(ss); ss = xor32_sum(ss);
                if (fq == 0) __builtin_amdgcn_raw_buffer_store_b32(__float_as_uint(ss), ssrc, (row * 16 + u.pn * 4 + wc) * 4, 0, 16); }
            asm volatile("" ::: "memory"); }
        asm volatile("s_waitcnt vmcnt(0)" ::: "memory");
        unsigned* w = fin + 16 * u.pm;
        if (hw_lane() == 0) __hip_atomic_fetch_add(w, 1u, __ATOMIC_RELAXED, __HIP_MEMORY_SCOPE_AGENT);
        { unsigned polls = 0; while ((unsigned)__builtin_amdgcn_readfirstlane(__hip_atomic_load(w, __ATOMIC_RELAXED, __HIP_MEMORY_SCOPE_AGENT)) < 32u && ++polls < (1u << 20)) __builtin_amdgcn_s_sleep(2); }
        float rs[2][4];
#pragma unroll
        for (int ai = 0; ai < 2; ++ai)
#pragma unroll
            for (int m = 0; m < 4; ++m) { const int row = row0 + ai * 128 + m * 16;
                const gp::u32x4 p = __builtin_amdgcn_raw_buffer_load_b128(ssrc, (row * 16 + 4 * fq) * 4, 0, 17);
                float t = (__uint_as_float(p.x) + __uint_as_float(p.y)) + (__uint_as_float(p.z) + __uint_as_float(p.w));
                t += swz_xor<16>(t); t = xor32_sum(t);
                rs[ai][m] = 1.0f / sqrtf(t * (1.0f / 1024.0f) + 1e-6f); }
        gp::f32x4 gv[2][2];
#pragma unroll
        for (int bj = 0; bj < 2; ++bj)
#pragma unroll
            for (int n = 0; n < 2; ++n) gv[bj][n] = *(const gp::f32x4*)(fg + col0 + bj * 128 + 4 * n);
#pragma unroll
        for (int ai = 0; ai < 2; ++ai)
#pragma unroll
            for (int m = 0; m < 4; ++m) { const float r = rs[ai][m]; float* op = out + (size_t)(row0 + ai * 128 + m * 16) * 1024 + col0;
#pragma unroll
                for (int bj = 0; bj < 2; ++bj) { const gp::u32x4 h = g[ai][m][bj];
                    *(gp::f32x4*)(op + bj * 128) = (gp::f32x4){bflo(h.x) * r * gv[bj][0][0], bfhi(h.x) * r * gv[bj][0][1], bflo(h.y) * r * gv[bj][0][2], bfhi(h.y) * r * gv[bj][0][3]};
                    *(gp::f32x4*)(op + bj * 128 + 4) = (gp::f32x4){bflo(h.z) * r * gv[bj][1][0], bfhi(h.z) * r * gv[bj][1][1], bflo(h.w) * r * gv[bj][1][2], bfhi(h.w) * r * gv[bj][1][3]}; } }
    }
};

__device__ __forceinline__ void router_phase(LAS unsigned char* lds, const bf16* H, const bf16* WRT, const float* rg_b, const float* re_b, float* RSTD2, int* VTOK, float* VW, unsigned* cnt,
                                             const int vcu, const int G, const int wave, const int lane, const int tid) {
    typedef short bf16x8 __attribute__((ext_vector_type(8))); typedef float f32x16 __attribute__((ext_vector_type(16)));
    LAS float* part = (LAS float*)lds;
    LAS float* ssqp = (LAS float*)(lds + 40960);
    LAS unsigned* hist = (LAS unsigned*)(lds + 40960 + 1024);
    LAS unsigned* base = hist + 32;
    const int r = lane & 31, hh = lane >> 5, item = wave >> 2, kq = wave & 3;
    LAS float* biasl = (LAS float*)(lds + 40960 + 1024 + 256);
    if (tid < 36) biasl[tid] = (tid < 4) ? rg_b[tid] : re_b[tid - 4];
    for (int tb = vcu; tb < T_ / 64; tb += G) {
        __syncthreads();
        if (tid < 32) hist[tid] = 0u;
        const size_t t_base = (size_t)tb * 64 + 32 * item;
        constexpr int BST = 1040;
        LAS unsigned char* bt = lds + 49152;
        f32x16 acc[3];
#pragma unroll
        for (int nb = 0; nb < 3; ++nb)
#pragma unroll
            for (int i = 0; i < 16; ++i) acc[nb][i] = 0.f;
        float ssq = 0.f;
        const bf16* ap = H + (t_base + r) * 1024 + 128 * kq + 8 * hh;
        v4u areg[2][8];
#pragma unroll
        for (int kh = 0; kh < 2; ++kh)
#pragma unroll
            for (int q = 0; q < 8; ++q) areg[kh][q] = *(const v4u*)(ap + 512 * kh + 16 * q);
#pragma unroll
        for (int kh = 0; kh < 2; ++kh) {
            if (kh) __syncthreads();
            { v4u tv[9];
#pragma unroll
              for (int i = 0; i < 9; ++i) { const int id = tid + 512 * i, row = id >> 6, c = id & 63; const int wrow = row < 68 ? row : row + 28;
                  tv[i] = *(const v4u*)(WRT + (size_t)wrow * 1024 + 512 * kh + 8 * c); }
#pragma unroll
              for (int i = 0; i < 9; ++i) { const int id = tid + 512 * i, row = id >> 6, c = id & 63; *(LAS v4u*)(bt + row * BST + 16 * c) = tv[i]; } }
            __syncthreads();
            const LAS unsigned char* bq = bt + r * BST + (128 * kq + 8 * hh) * 2;
#pragma unroll
            for (int q = 0; q < 8; ++q) { const v4u araw = areg[kh][q];
#pragma unroll
                for (int e = 0; e < 4; ++e) { const float x0 = bflo(araw[e]), x1 = bfhi(araw[e]); ssq += x0 * x0 + x1 * x1; }
                const bf16x8 af = __builtin_bit_cast(bf16x8, araw);
#pragma unroll
                for (int nb = 0; nb < 3; ++nb) { const bf16x8 bfr = *(const LAS bf16x8*)(bq + 32 * nb * BST + 32 * q); acc[nb] = __builtin_amdgcn_mfma_f32_32x32x16_bf16(af, bfr, acc[nb], 0, 0, 0); } }
        }
#pragma unroll
        for (int i = 0; i < 16; ++i) { const int tk = (i & 3) + 8 * (i >> 2) + 4 * hh; LAS float* p = part + (wave * 32 + tk) * 40;
            p[r] = acc[0][i] + acc[1][i]; if (r < 8) p[32 + r] = acc[2][i]; }
        ssq += __uint_as_float(__builtin_amdgcn_permlane32_swap(__float_as_uint(ssq), __float_as_uint(ssq), false, false)[hh ? 0 : 1]);
        if (hh == 0) ssqp[wave * 32 + r] = ssq;
        __syncthreads();
        int ea = 0, eb = 0; float wa = 0.f, wb = 0.f, rs = 0.f; unsigned ra = 0u, rb = 0u;
        if (tid < 64) {
            const int it = tid >> 5, tk = tid & 31;
            float lg36[36]; float ss = 0.f;
#pragma unroll
            for (int j = 0; j < 36; ++j) lg36[j] = 0.f;
#pragma unroll
            for (int w4 = 0; w4 < 4; ++w4) { const LAS float* p = part + ((it * 4 + w4) * 32 + tk) * 40; ss += ssqp[(it * 4 + w4) * 32 + tk];
#pragma unroll
                for (int q = 0; q < 9; ++q) { const f32x4 v = *(const LAS f32x4*)(p + 4 * q); lg36[4 * q] += v.x; lg36[4 * q + 1] += v.y; lg36[4 * q + 2] += v.z; lg36[4 * q + 3] += v.w; }
                { const f32x4 v = *(const LAS f32x4*)(p + 36); lg36[32] += v.x; lg36[33] += v.y; lg36[34] += v.z; lg36[35] += v.w; } }
            rs = 1.0f / sqrtf(ss * (1.0f / 1024.0f) + 1e-6f);
            float lg[4];
#pragma unroll
            for (int j = 0; j < 4; ++j) lg[j] = lg36[j] * rs + biasl[j];
            int gi = 0; float gm = lg[0];
#pragma unroll
            for (int j = 1; j < 4; ++j) if (lg[j] > gm) { gm = lg[j]; gi = j; }
            float gs = 0.f;
#pragma unroll
            for (int j = 0; j < 4; ++j) gs += expf(lg[j] - gm);
            const float gwt = 1.0f / gs;
            float el[8];
#pragma unroll
            for (int j = 0; j < 8; ++j) { float v = lg36[4 + j]; float bb = biasl[4 + j];
#pragma unroll
                for (int g = 1; g < 4; ++g) { v = (gi == g) ? lg36[4 + 8 * g + j] : v; bb = (gi == g) ? biasl[4 + 8 * g + j] : bb; }
                el[j] = v * rs + bb; }
            int i0 = 0; float m0 = el[0];
#pragma unroll
            for (int j = 1; j < 8; ++j) if (el[j] > m0) { m0 = el[j]; i0 = j; }
            int i1 = -1; float m1 = -INFINITY;
#pragma unroll
            for (int j = 0; j < 8; ++j) if (j != i0 && el[j] > m1) { m1 = el[j]; i1 = j; }
            const float e1 = expf(m1 - m0); wa = gwt / (1.0f + e1); wb = gwt * e1 / (1.0f + e1);
            ea = gi * 8 + i0; eb = gi * 8 + i1;
            ra = __hip_atomic_fetch_add(hist + ea, 1u, __ATOMIC_RELAXED, __HIP_MEMORY_SCOPE_WORKGROUP); rb = __hip_atomic_fetch_add(hist + eb, 1u, __ATOMIC_RELAXED, __HIP_MEMORY_SCOPE_WORKGROUP);
        }
        __syncthreads();
        if (tid < 32) { const unsigned c = hist[tid]; base[tid] = c ? __hip_atomic_fetch_add(cnt + tid, c, __ATOMIC_RELAXED, __HIP_MEMORY_SCOPE_AGENT) : 0u; }
        __syncthreads();
        if (tid < 64) { const size_t t = (size_t)tb * 64 + tid;
            const size_t sa = (size_t)ea * VCAP + base[ea] + ra, sb_ = (size_t)eb * VCAP + base[eb] + rb;
            RSTD2[t] = rs; VTOK[sa] = (int)(2 * t); VW[sa] = wa; VTOK[sb_] = (int)(2 * t + 1); VW[sb_] = wb; }
    }
}
__device__ __forceinline__ void combine_phase(bf16* H, const bf16* Y, float* RSTD3, int gw, int NGW, int lane) {
    for (int t = gw; t < T_; t += NGW) {
        v4u* hr = (v4u*)(H + (size_t)t * 1024) + lane; const v4u* y0 = (const v4u*)(Y + (size_t)t * 1024) + lane; const v4u* y1 = (const v4u*)(Y + ((size_t)T_ + t) * 1024) + lane; float ss = 0.f;
#pragma unroll
        for (int j = 0; j < 2; ++j) { const v4u h = hr[64 * j], a = y0[64 * j], b = y1[64 * j]; v4u o;
#pragma unroll
            for (int e = 0; e < 4; ++e) { o[e] = pk2(bflo(h[e]) + bflo(a[e]) + bflo(b[e]), bfhi(h[e]) + bfhi(a[e]) + bfhi(b[e])); ss += bflo(o[e]) * bflo(o[e]) + bfhi(o[e]) * bfhi(o[e]); }
            hr[64 * j] = o; }
        ss = wave_sum(ss); if (lane == 0) RSTD3[t] = 1.0f / sqrtf(ss * (1.0f / 1024.0f) + 1e-6f);
    }
}
__device__ __forceinline__ void final_phase(const bf16* H, float* out, const float* g, int gw, int NGW, int lane) {
    for (int t = gw; t < T_; t += NGW) {
        const v4u* hr = (const v4u*)(H + (size_t)t * 1024) + lane; v4u v[2]; float ss = 0.f;
#pragma unroll
        for (int j = 0; j < 2; ++j) { v[j] = hr[64 * j];
#pragma unroll
            for (int e = 0; e < 4; ++e) ss += bflo(v[j][e]) * bflo(v[j][e]) + bfhi(v[j][e]) * bfhi(v[j][e]); }
        ss = wave_sum(ss); const float rs = 1.0f / sqrtf(ss * (1.0f / 1024.0f) + 1e-6f);
        f32x4* o = (f32x4*)(out + (size_t)t * 1024);
#pragma unroll
        for (int j = 0; j < 2; ++j) { const int c8 = 64 * j + lane; const f32x4 g0 = ((const f32x4*)g)[2 * c8], g1 = ((const f32x4*)g)[2 * c8 + 1];
            o[2 * c8] = (f32x4){bflo(v[j][0]) * rs * g0.x, bfhi(v[j][0]) * rs * g0.y, bflo(v[j][1]) * rs * g0.z, bfhi(v[j][1]) * rs * g0.w};
            o[2 * c8 + 1] = (f32x4){bflo(v[j][2]) * rs * g1.x, bfhi(v[j][2]) * rs * g1.y, bflo(v[j][3]) * rs * g1.z, bfhi(v[j][3]) * rs * g1.w}; }
    }
}
struct MArgs { const float* in[23]; float* out; unsigned char* ws; };
__device__ __forceinline__ void* lds_ptr(LAS unsigned char* lds, int i) {
    unsigned off = LDS_MISC + 512; asm volatile("" : "+v"(off));
    const volatile LAS unsigned* q = (const volatile LAS unsigned*)(lds + off) + 2 * i;
    const unsigned lo = __builtin_amdgcn_readfirstlane(q[0]), hi = __builtin_amdgcn_readfirstlane(q[1]);
    typedef __attribute__((address_space(1))) char gchar;
    return (void*)(gchar*)(((unsigned long long)hi << 32) | lo);
}

#define ARGP(i) ((const float*)lds_ptr(lds, (i)))
#define WSP() ((unsigned char*)lds_ptr(lds, 24))
#define HFP() ((float*)lds_ptr(lds, 23))
#define PHASE_IDS() const int lane = hw_lane(); const int tid = wave * 64 + lane; const int gw = vcu * NWAVES + wave; const int gtid = (int)blockIdx.x * NTHREADS + tid; (void)lane; (void)gw; (void)gtid
template <int l> __device__ __forceinline__ void layer_body(LAS unsigned char* lds, const XcdBarrier& bar, volatile LAS int* toffs, const int wave, const int vcu, const int G) {
    constexpr long T = T_; constexpr int D = 1024, DPROJ = 2576, PLE = 256, NE = 32, DE = 256;
    const int NGW = G * NWAVES, GT = G * NTHREADS;
#define LAYER_PTRS() unsigned char* ws = WSP(); bf16* Ha = (bf16*)(ws + OFF_HB) + (size_t)(l & 1) * T_ * 1024; bf16* Hb = (bf16*)(ws + OFF_HB) + (size_t)((l + 1) & 1) * T_ * 1024; unsigned* cnt = (unsigned*)ws + CW_CNT + 64 * l; unsigned* fill = (unsigned*)ws + CW_FILL + 64 * l; \
        float* RSTD1 = (float*)(ws + OFF_RSTD); float* RSTD2 = RSTD1 + T_; float* RSTD3 = RSTD2 + T_; (void)Ha; (void)Hb; (void)cnt; (void)fill; (void)RSTD1; (void)RSTD2; (void)RSTD3
        if constexpr (l == 0) {
        { PHASE_IDS(); LAYER_PTRS();
          LayerIn I; I.x = ARGP(0); I.pl = ARGP(1) + (size_t)l * T * PLE; I.norm1_g = ARGP(2) + (size_t)l * D; I.w_in = ARGP(3) + (size_t)l * D * DPROJ; I.w_out = ARGP(9) + (size_t)l * D * D; I.norm2_g = ARGP(10) + (size_t)l * D;
          I.rg_w = ARGP(11) + (size_t)l * D * 4; I.re_w = ARGP(13) + (size_t)l * D * 32; I.wg = ARGP(15) + (size_t)l * NE * D * DE; I.wu = ARGP(16) + (size_t)l * NE * D * DE; I.wd = ARGP(17) + (size_t)l * NE * DE * D;
          I.ple_g = ARGP(18) + (size_t)l * D; I.ple_w = ARGP(19) + (size_t)l * D * D; I.ple_p = ARGP(21) + (size_t)l * PLE * D; I.pool_w = ARGP(7) + (size_t)l * 4 * 64 * 64;
          int GT_ = GT, NGW_ = NGW; asm volatile("" : "+s"(GT_), "+s"(NGW_));
          prologue_phase<0>(lds, I, ws, (unsigned char*)HFP(), l, gw, NGW_, wave, lane, gtid, GT_); }
        xcd_barrier(bar);
        }
        { LAYER_PTRS(); ProjESched S; S.init(Ha, ws + OFF_WIN, (unsigned char*)HFP() + OB_PB, (unsigned char*)HFP() + OB_WPP, G, (int)blockIdx.x);
          EpiProjE<(l > 0)> E{EpiProj<(l > 0)>{(bf16*)(ws + OFF_PROJ), (l > 0) ? (const float*)(ws + OFF_SS) : RSTD1}, EpiE{(bf16*)(ws + OFF_EB)}};
          gp::gemm_phase<EpiProjE<(l > 0)>, ProjESched>(lds, S, E, 1024, 1024, wave); }
        xcd_barrier(bar);
        { PHASE_IDS(); LAYER_PTRS();
          gla::G1Args ga{(const bf16*)(ws + OFF_PROJ), ARGP(4) + (size_t)l * 16 * 192, ARGP(5) + (size_t)l * 192, (bf16*)(ws + OFF_QD), (bf16*)(ws + OFF_KI), (float*)(ws + OFF_KVT), (float*)(ws + OFF_DEC),
                         (const bf16*)(ws + OFF_WPL), ARGP(8) + (size_t)l * 256, (bf16*)(ws + OFF_MIX)};
          gla::gla1_phase<false>(lds, ga, vcu, G, wave, lane, tid);
          __syncthreads();
          sb::sb_phase(lds, (const bf16*)(ws + OFF_PROJ), (bf16*)(ws + OFF_MIX), vcu, G, wave, lane);
          if (wave >= 4) for (int ch = vcu; ch < 256; ch += G)
              gla::pool_wave(lds + wave * sb::VT_BYTES, lds + 8 * sb::VT_BYTES + (wave - 4) * (64 * gla::UST), (const bf16*)(ws + OFF_PROJ), (const bf16*)(ws + OFF_WPL), ARGP(8) + (size_t)l * 256, (bf16*)(ws + OFF_MIX), ch, wave - 4, lane); }
        xcd_barrier(bar);
        gla::G3Pre g3p;
        { PHASE_IDS(); LAYER_PTRS(); gla::gla2_phase((const float*)(ws + OFF_KVT), (const float*)(ws + OFF_DEC), (bf16*)(ws + OFF_STB), gtid, GT);
          gla::G3Args ga3{(const bf16*)(ws + OFF_PROJ), (const bf16*)(ws + OFF_QD), (const bf16*)(ws + OFF_KI), (const bf16*)(ws + OFF_STB), ARGP(6) + (size_t)l * 96, (bf16*)(ws + OFF_MIX)};
          if (vcu < 256) gla::gla3_pre(lds, ga3, vcu, wave, lane, tid, g3p); }
        xcd_barrier(bar);
        { PHASE_IDS(); LAYER_PTRS();
          gla::G3Args ga{(const bf16*)(ws + OFF_PROJ), (const bf16*)(ws + OFF_QD), (const bf16*)(ws + OFF_KI), (const bf16*)(ws + OFF_STB), ARGP(6) + (size_t)l * 96, (bf16*)(ws + OFF_MIX)};
          gla::gla3_phase(lds, ga, vcu, G, wave, lane, tid, g3p); }
        xcd_barrier(bar);
        { LAYER_PTRS(); PlainSched S; S.init(ws + OFF_MIX, ws + OFF_WOUT, T_, 1024, 1024, 1024, 1024, G, (int)blockIdx.x);
          EpiOut E{Ha};
          gp::gemm_phase<EpiOut, PlainSched>(lds, S, E, 1024, 1024, wave); }
        xcd_barrier(bar);
        { PHASE_IDS(); LAYER_PTRS(); router_phase(lds, Ha, (const bf16*)(ws + OFF_WR), ARGP(12) + (size_t)l * 4, ARGP(14) + (size_t)l * 32, RSTD2, (int*)(ws + OFF_VTOK), (float*)(ws + OFF_VW), cnt, vcu, G, wave, lane, tid); }
        xcd_barrier(bar);
        { PHASE_IDS(); LAYER_PTRS(); compute_toffs(toffs, cnt, tid); }
        { LAYER_PTRS(); MoeUpSched S; S.toffs = toffs; S.G = G; S.c = vcu  ; S.A = (const char*)Ha; S.Bt = (const char*)(ws + OFF_WGU); S.lrow = (const int*)(ws + OFF_VTOK); S.ready = (unsigned*)ws + CW_RDY + 4096 * l;
          EpiUp E{(bf16*)(ws + OFF_HID), RSTD2};
          gp::gemm_phase<EpiUp, MoeUpSched>(lds, S, E, 1024, 1024, wave); }
        { LAYER_PTRS(); MoeDownSched<false> S; S.toffs = toffs; S.G = G; S.c = vcu  ; S.A = (const char*)(ws + OFF_HID); S.Bt = (const char*)(ws + OFF_WD); S.vtok = (const int*)(ws + OFF_VTOK);
          S.wait_tiles((unsigned*)ws + CW_RDY + 4096 * l, wave);
          EpiDown E{(bf16*)(ws + OFF_Y)};
          gp::gemm_phase<EpiDown, MoeDownSched<false>>(lds, S, E, 256, 256, wave); }
        { LAYER_PTRS(); MoeDownSched<true> S; S.toffs = toffs; S.G = G; S.c = vcu  ; S.A = (const char*)(ws + OFF_HID); S.Bt = (const char*)(ws + OFF_WD); S.vtok = (const int*)(ws + OFF_VTOK);
          S.wait_tiles((unsigned*)ws + CW_RDY + 4096 * l, wave);
          EpiDown E{(bf16*)(ws + OFF_Y)};
          gp::gemm_phase<EpiDown, MoeDownSched<true>>(lds, S, E, 256, 256, wave); }
        xcd_barrier(bar);
        { PHASE_IDS(); LAYER_PTRS(); combine_phase(Ha, (const bf16*)(ws + OFF_Y), RSTD3, gw, NGW, lane); }
        if constexpr (l == 0) {
          PHASE_IDS(); LAYER_PTRS(); constexpr int ln = l + 1;
          LayerIn I; I.x = ARGP(0); I.pl = ARGP(1) + (size_t)ln * T * PLE; I.norm1_g = ARGP(2) + (size_t)ln * D; I.w_in = ARGP(3) + (size_t)ln * D * DPROJ; I.w_out = ARGP(9) + (size_t)ln * D * D; I.norm2_g = ARGP(10) + (size_t)ln * D;
          I.rg_w = ARGP(11) + (size_t)ln * D * 4; I.re_w = ARGP(13) + (size_t)ln * D * 32; I.wg = ARGP(15) + (size_t)ln * NE * D * DE; I.wu = ARGP(16) + (size_t)ln * NE * D * DE; I.wd = ARGP(17) + (size_t)ln * NE * DE * D;
          I.ple_g = ARGP(18) + (size_t)ln * D; I.ple_w = ARGP(19) + (size_t)ln * D * D; I.ple_p = ARGP(21) + (size_t)ln * PLE * D; I.pool_w = ARGP(7) + (size_t)ln * 4 * 64 * 64;
          int GT_ = GT, NGW_ = NGW; asm volatile("" : "+s"(GT_), "+s"(NGW_));
          prologue_phase<1>(lds, I, ws, (unsigned char*)HFP(), ln, gw, NGW_, wave, lane, gtid, GT_); }
        xcd_barrier(bar);
        if constexpr (l == 0) {
          { LAYER_PTRS(); PlainSched S; S.init(Ha, ws + ((l & 1) ? OFF_PB : OFF_WPG), T_, 1024, 1024, 1024, 1024, G, (int)blockIdx.x);
            EpiPle E{Ha, Hb, (const bf16*)(ws + OFF_EB), RSTD3, ARGP(20) + (size_t)l * D, (float*)(ws + OFF_SS)};
            gp::gemm_phase<EpiPle, PlainSched>(lds, S, E, 1024, 1024, wave); }
          xcd_barrier(bar);
        } else {
          { LAYER_PTRS(); PlainSched S; S.init(Ha, ws + ((l & 1) ? OFF_PB : OFF_WPG), T_, 1024, 1024, 1024, 1024, G, (int)blockIdx.x);
            EpiPleFinal E{Ha, (const bf16*)(ws + OFF_EB), RSTD3, ARGP(20) + (size_t)l * D, (float*)(ws + OFF_SS), (unsigned*)ws + CW_FIN, ARGP(22), HFP()};
            gp::gemm_phase<EpiPleFinal, PlainSched>(lds, S, E, 1024, 1024, wave); }
        }
#undef LAYER_PTRS

}
__global__ void __launch_bounds__(NTHREADS, 2) mega_fwd(MArgs a) {
    extern __shared__ __attribute__((aligned(16))) unsigned char lds_raw[];
    LAS unsigned char* lds = (LAS unsigned char*)lds_raw;
    volatile LAS unsigned* misc = (volatile LAS unsigned*)(lds + LDS_MISC);
    volatile LAS int* toffs = (volatile LAS int*)(lds + LDS_MISC + 256);
    if (threadIdx.x < 16) misc[threadIdx.x] = 0u;
    __syncthreads();
    const XcdBarrier bar = xcd_barrier_post((unsigned*)a.ws, misc);
    const int wave = __builtin_amdgcn_readfirstlane(threadIdx.x >> 6);
    const int G = gridDim.x; const int vcu = (G % 8 == 0) ? ((int)blockIdx.x % 8) * (G / 8) + (int)blockIdx.x / 8 : (int)blockIdx.x;
    if (threadIdx.x < 25) ((volatile LAS unsigned long long*)(lds + LDS_MISC + 512))[threadIdx.x] = (threadIdx.x < 23) ? (unsigned long long)a.in[threadIdx.x < 23 ? threadIdx.x : 0] : (threadIdx.x == 23 ? (unsigned long long)a.out : (unsigned long long)a.ws);
    __syncthreads();
    const int NGW = G * NWAVES; (void)NGW;
    layer_body<0>(lds, bar, toffs, wave, vcu, G);
    layer_body<1>(lds, bar, toffs, wave, vcu, G);
#undef PHASE_IDS
#undef ARGP
#undef WSP
#undef HFP
}

extern "C" void kernel_launch(void* const* d_in, const int* in_sizes, int n_in, void* d_out, int out_size, void* d_ws, size_t ws_size, hipStream_t stream) {
    static int grid = 0;
    if (grid == 0) {
        int dev = 0, cus = 0, per_cu = 0;
        if (hipGetDevice(&dev) != hipSuccess || hipDeviceGetAttribute(&cus, hipDeviceAttributeMultiprocessorCount, dev) != hipSuccess) { grid = -1; return; }
        if (hipFuncSetAttribute((const void*)mega_fwd, hipFuncAttributeMaxDynamicSharedMemorySize, LDS_BYTES) != hipSuccess) { fprintf(stderr, "kernel_launch: hipFuncSetAttribute failed\n"); grid = -1; return; }
        if (hipOccupancyMaxActiveBlocksPerMultiprocessor(&per_cu, (const void*)mega_fwd, NTHREADS, LDS_BYTES) != hipSuccess || per_cu < 1) { fprintf(stderr, "kernel_launch: occupancy query says %d blocks per CU\n", per_cu); (void)hipGetLastError(); grid = -1; return; }
        grid = cus;
        if (WS_END > ws_size) { fprintf(stderr, "kernel_launch: workspace too small: need %zu have %zu\n", (size_t)WS_END, ws_size); grid = -1; return; }
    }
    if (grid < 0) return;
    if (hipMemsetAsync(d_ws, 0, CTL_BYTES, stream) != hipSuccess) return;
    MArgs a{};
    for (int i = 0; i < 23; ++i) a.in[i] = (const float*)d_in[i];
    a.out = (float*)d_out; a.ws = (unsigned char*)d_ws;
    hipLaunchKernelGGL(mega_fwd, dim3(grid), dim3(NTHREADS), LDS_BYTES, stream, a);
}
```
